# Optimizing an MI355X kernel written in HIP

```python
import jax, jax.numpy as jnp
from jax import lax
import numpy as np

D_MODEL = 1024
BATCH = 8
SEQ = 2048
DEPTH = 1
DEC_BATCH = 128
DEC_SEQ = 1
PAST_LEN = 16384
PAGE_SIZE = 128

D_MIX = D_MODEL
D_A = D_MIX // 2
D_B = D_MIX - D_A
N_HEADS_A = 8
HEAD_DIM_A = D_A // N_HEADS_A
N_GROUPS_B = 8
CHUNK = 128
CONV_W = 3
D_FF = 4 * D_MODEL
N_MOD = 6
D_IN = 2 * D_A + 3 * D_B
EPS = 1e-6

kernel_name = 'hymba_gmlp_shortconv_step'


def rmsnorm(x, g):
    xf = x.astype(jnp.float32)
    y = xf * lax.rsqrt(jnp.mean(jnp.square(xf), axis=-1, keepdims=True) + EPS)
    return (y * g.astype(jnp.float32)).astype(x.dtype)


def chunk_spatial_mix(v, w_s, b_s):
    bsz, t, h, dh = v.shape
    n_chunks = -(-t // CHUNK)
    pad = n_chunks * CHUNK - t
    vp = jnp.pad(v, ((0, 0), (0, pad), (0, 0), (0, 0)))
    vc = vp.reshape(bsz, n_chunks, CHUNK, h, dh)
    wm = jnp.tril(w_s)
    out = jnp.einsum('hts,bnshd->bnthd', wm, vc) + jnp.transpose(b_s)[None, None, :, :, None]
    return out.reshape(bsz, n_chunks * CHUNK, h, dh)[:, :t]


def short_conv(z, prev, w_conv):
    t = z.shape[1]
    zp = jnp.concatenate([prev, z], axis=1)
    y = w_conv[0] * zp[:, 0:t]
    for k in range(1, CONV_W):
        y = y + w_conv[k] * zp[:, k:k + t]
    return y, zp[:, -(CONV_W - 1):]


def layer(x, c, conv_prev, g_mix, w_ada, b_ada, w_in, g_v, w_s, b_s, w_conv, w_out,
          g_ffn, w_ff1, w_ff2):
    bsz, t, _ = x.shape
    mod = jax.nn.silu(c) @ w_ada + b_ada
    sh1, sc1, gt1, sh2, sc2, gt2 = [m[:, None, :] for m in jnp.split(mod, N_MOD, axis=-1)]

    h = rmsnorm(x, g_mix) * (1.0 + sc1) + sh1
    p = h @ w_in
    u, v, bg, cg, hin = jnp.split(p, [D_A, 2 * D_A, 2 * D_A + D_B, 2 * D_A + 2 * D_B], axis=-1)
    u = jax.nn.gelu(u)
    v = rmsnorm(jax.nn.gelu(v).reshape(bsz, t, N_HEADS_A, HEAD_DIM_A),
                g_v.reshape(N_HEADS_A, HEAD_DIM_A))
    a_out = u * chunk_spatial_mix(v, w_s, b_s).reshape(bsz, t, D_A)
    y_conv, new_conv = short_conv(cg * hin, conv_prev, w_conv)
    b_out = bg * y_conv
    mix = jnp.concatenate([a_out, b_out], axis=-1) @ w_out
    x = x + gt1 * mix

    h2 = rmsnorm(x, g_ffn) * (1.0 + sc2) + sh2
    f = jnp.square(jax.nn.relu(h2 @ w_ff1)) @ w_ff2
    x = x + gt2 * f
    return x, v.reshape(bsz, t, D_A), new_conv


def setup_inputs(seed: int = 0) -> dict:
    key = jax.random.key(seed)
    ks = jax.random.split(key, 20)
    nrm = lambda k, s: jax.random.normal(k, s, jnp.float32)
    return {
        'x_prompt': nrm(ks[0], (BATCH, SEQ, D_MODEL)),
        'x_sample': nrm(ks[1], (DEC_BATCH, DEC_SEQ, D_MODEL)),
        'c_prompt': nrm(ks[2], (BATCH, D_MODEL)),
        'c_sample': nrm(ks[3], (DEC_BATCH, D_MODEL)),
        'state_conv': nrm(ks[4], (DEPTH, DEC_BATCH, CONV_W - 1, D_B)),
        'g_mix': 1.0 + 0.02 * nrm(ks[5], (DEPTH, D_MODEL)),
        'w_ada': nrm(ks[6], (DEPTH, D_MODEL, N_MOD * D_MODEL)) * D_MODEL ** -0.5,
        'b_ada': 0.02 * nrm(ks[7], (DEPTH, N_MOD * D_MODEL)),
        'w_in': nrm(ks[8], (DEPTH, D_MODEL, D_IN)) * D_MODEL ** -0.5,
        'g_v': 1.0 + 0.02 * nrm(ks[9], (DEPTH, D_A)),
        'w_s': nrm(ks[10], (DEPTH, N_HEADS_A, CHUNK, CHUNK)) * CHUNK ** -0.5,
        'b_s': 1.0 + 0.02 * nrm(ks[11], (DEPTH, N_HEADS_A, CHUNK)),
        'w_conv': nrm(ks[12], (DEPTH, CONV_W, D_B)) * CONV_W ** -0.5,
        'w_out': nrm(ks[13], (DEPTH, D_MIX, D_MODEL)) * D_MIX ** -0.5,
        'g_ffn': 1.0 + 0.02 * nrm(ks[14], (DEPTH, D_MODEL)),
        'w_ff1': nrm(ks[15], (DEPTH, D_MODEL, D_FF)) * D_MODEL ** -0.5,
        'w_ff2': nrm(ks[16], (DEPTH, D_FF, D_MODEL)) * D_FF ** -0.5,
        'g_final': 1.0 + 0.02 * nrm(ks[17], (D_MODEL,)),
    }


def reference(x_prompt, x_sample, c_prompt, c_sample, state_conv, g_mix, w_ada, b_ada,
              w_in, g_v, w_s, b_s, w_conv, w_out, g_ffn, w_ff1, w_ff2, g_final):
    xp, xs = x_prompt, x_sample
    conv_p_list, conv_s_list, v_s_list = [], [], []
    for l in range(DEPTH):
        wl = (g_mix[l], w_ada[l], b_ada[l], w_in[l], g_v[l], w_s[l], b_s[l], w_conv[l],
              w_out[l], g_ffn[l], w_ff1[l], w_ff2[l])
        prev_p = jnp.zeros((xp.shape[0], CONV_W - 1, D_B), xp.dtype)
        xp, _, conv_p = layer(xp, c_prompt, prev_p, *wl)
        xs, v_s, conv_s = layer(xs, c_sample, state_conv[l], *wl)
        conv_p_list.append(conv_p)
        conv_s_list.append(conv_s)
        v_s_list.append(v_s)
    y_prompt = rmsnorm(xp, g_final)
    y_sample = rmsnorm(xs, g_final)
    new_conv_prompt = jnp.stack(conv_p_list)
    new_conv_sample = jnp.stack(conv_s_list)
    new_chunk_v_sample = jnp.stack(v_s_list)
    return (y_prompt, y_sample, new_conv_prompt, new_conv_sample, new_chunk_v_sample)
```

```cpp
#include <hip/hip_runtime.h>
#include <hip/hip_cooperative_groups.h>
#include <cstdio>
namespace cg = cooperative_groups;

#define LAS __attribute__((address_space(3)))
typedef unsigned short bf16_t;
typedef short bf16x8 __attribute__((ext_vector_type(8)));
typedef float f32x4 __attribute__((ext_vector_type(4)));

constexpr int DM = 1024, NP = 16384, NTOK = 16512, MPAD = 16640, NB = 136, NMOD = 6144, DIN = 2560, DFF = 4096;
constexpr int BM = 256, BK = 64, HALF = 128, HTB = HALF * BK * 2, STAGE_BYTES = 8 * HTB, NXCD = 8, WGM = 4;
constexpr int LDS_BYTES = STAGE_BYTES;
constexpr float EPS = 1e-6f;
#define WGM_G1 8
#define WGM_G3 4
#define DUP 0

constexpr size_t WS_WIN = 0;
constexpr size_t WS_WOUT = WS_WIN + (size_t)DIN * DM * 2;
constexpr size_t WS_WFF1 = WS_WOUT + (size_t)DM * DM * 2;
constexpr size_t WS_WFF2 = WS_WFF1 + (size_t)DFF * DM * 2;
constexpr size_t WS_WTRIL = WS_WFF2 + (size_t)DM * DFF * 2;
constexpr size_t WS_MOD = WS_WTRIL + (size_t)8 * 128 * 128 * 2;
constexpr size_t WS_H = WS_MOD + (size_t)NB * NMOD * 4;
constexpr size_t WS_R = WS_H + (size_t)MPAD * DM * 2;
constexpr size_t WS_PU = WS_R;
constexpr size_t WS_PV = WS_PU + (size_t)MPAD * 512 * 2;
constexpr size_t WS_PBG = WS_PV + (size_t)MPAD * 512 * 2;
constexpr size_t WS_PZ = WS_PBG + (size_t)MPAD * 512 * 2;
constexpr size_t WS_MA = WS_PZ + (size_t)MPAD * 512 * 2;
constexpr size_t WS_WADA = WS_R + (size_t)MPAD * DFF * 2;
constexpr size_t WS_S = WS_WADA + (size_t)NMOD * DM * 2;
constexpr size_t WS_BAR = WS_S + (size_t)144 * DM * 2;
constexpr size_t WS_CNT = WS_BAR + 16384;
constexpr int CNT_BYTES = 36864, CNT_P4 = 0, CNT_P7 = 64, CNT_READY6 = 128, CNT_DONE7 = 129;
constexpr size_t WS_SLOT = WS_CNT + CNT_BYTES;
constexpr size_t WS_X1B = WS_SLOT + (size_t)2 * 64 * 4 * 256 * 4;
constexpr size_t WS_END = WS_X1B + (size_t)NP * DM * 2;
#define FUSE4 1
#define FUSE7 1
constexpr size_t O_Y = 0, O_CONVP = (size_t)NTOK * DM, O_CONVS = O_CONVP + 8 * 2 * 512, O_VS = O_CONVS + 128 * 2 * 512, O_END = O_VS + 128 * 512;

struct Params {
    const float *x_prompt, *x_sample, *c_prompt, *c_sample, *state_conv, *g_mix, *w_ada, *b_ada, *w_in, *g_v, *w_s, *b_s, *w_conv, *w_out, *g_ffn, *w_ff1, *w_ff2, *g_final;
    float* out; unsigned char* ws; int use_cg_sync; int pad0;
};

__device__ __forceinline__ unsigned cvt_pk_bf16(float lo, float hi) { unsigned r; asm("v_cvt_pk_bf16_f32 %0, %1, %2" : "=v"(r) : "v"(lo), "v"(hi)); return r; }
__device__ __forceinline__ float bf_lo(unsigned u) { return __uint_as_float(u << 16); }
__device__ __forceinline__ float bf_hi(unsigned u) { return __uint_as_float(u & 0xffff0000u); }
__device__ __forceinline__ float gelu_tanh(float x) { const float u = 1.5957691216f * (x + 0.044715f * x * x * x); return x * __builtin_amdgcn_rcpf(1.f + __expf(-u)); }
__device__ __forceinline__ float silu_f(float x) { return x * __builtin_amdgcn_rcpf(1.f + __expf(-x)); }
__device__ __forceinline__ void st_bf16x4(bf16_t* p, f32x4 v) { uint2 o; o.x = cvt_pk_bf16(v[0], v[1]); o.y = cvt_pk_bf16(v[2], v[3]); *(uint2*)p = o; }
__device__ __forceinline__ int batch_of(int row) { return row < NP ? (row >> 11) : (row < NTOK ? 8 + row - NP : NB - 1); }
union Frag { bf16x8 v; unsigned u[4]; uint4 q; };
__device__ __forceinline__ void unpack8(const uint4 q, float (&f)[8]) { f[0] = bf_lo(q.x); f[1] = bf_hi(q.x); f[2] = bf_lo(q.y); f[3] = bf_hi(q.y); f[4] = bf_lo(q.z); f[5] = bf_hi(q.z); f[6] = bf_lo(q.w); f[7] = bf_hi(q.w); }
__device__ __forceinline__ int fresh_tid() { int t = threadIdx.x; asm volatile("" : "+v"(t)); return t; }


#define XB_TMO      128
#define XB_XCNT(j)  (256  + 64 * (j))
#define XB_XSUB(j)  (1280 + 64 * (j))
#define XB_XGEN(j)  (2304 + 64 * (j))
#define XB_TOP      3328
#define XB_TOPGEN   3392
#define XCD_BAR_WORDS 3456
#define XB_SPIN_CAP (1u << 18)
__device__ __forceinline__ unsigned xb_ld(unsigned* p)              { return __hip_atomic_load(p, __ATOMIC_RELAXED, __HIP_MEMORY_SCOPE_AGENT); }
__device__ __forceinline__ unsigned xb_add(unsigned* p, unsigned v) { return __hip_atomic_fetch_add(p, v, __ATOMIC_RELAXED, __HIP_MEMORY_SCOPE_AGENT); }
__device__ __forceinline__ unsigned xb_xcc_id() { return (unsigned)__builtin_amdgcn_s_getreg((3 << 11) | 20) & 0xFu; }
#define XB_SPIN(cond, bar) do { unsigned _sp = 0; while (cond) { __builtin_amdgcn_s_sleep(1); \
    if ((++_sp & 255u) == 0u) { if (xb_ld(&(bar)[XB_TMO])) break; if (_sp > XB_SPIN_CAP) { atomicAdd(&(bar)[XB_TMO], 1u); break; } } } } while (0)
struct XcdBarrier { unsigned* bar; unsigned x; volatile LAS unsigned* st; };
__device__ __forceinline__ XcdBarrier xcd_barrier_post(unsigned* bar, volatile LAS unsigned* st) {
    XcdBarrier b; b.bar = bar; b.x = xb_xcc_id(); b.st = st;
    if (threadIdx.x == 0) (void)xb_add(&bar[XB_XCNT(b.x)], 1u);
    return b;
}
__device__ __forceinline__ void xcd_barrier_complete(unsigned* bar, unsigned x, unsigned& nloc, unsigned& nx) {
    const unsigned G = gridDim.x * gridDim.y * gridDim.z;
    unsigned sum, cnt, mine, sp = 0u;
    for (;;) {
        sum = 0u; cnt = 0u; mine = 0u;
#pragma unroll
        for (unsigned j = 0; j < 16; ++j) { const unsigned c = xb_ld(&bar[XB_XCNT(j)]); sum += c; cnt += (c > 0u) ? 1u : 0u; mine = (j == x) ? c : mine; }
        if (sum == G) break;
        __builtin_amdgcn_s_sleep(1);
        if ((++sp & 255u) == 0u) { if (xb_ld(&bar[XB_TMO])) break; if (sp > XB_SPIN_CAP) { atomicAdd(&bar[XB_TMO], 1u); break; } }
    }
    nloc = mine > 0u ? mine : 1u; nx = cnt > 0u ? cnt : 1u;
}
__device__ __forceinline__ void xcd_barrier(const XcdBarrier& b) {
    asm volatile("s_waitcnt vmcnt(0)" ::: "memory");
    __syncthreads();
    if (threadIdx.x == 0) {
        unsigned* bar = b.bar;
        __builtin_amdgcn_s_waitcnt(0);
        unsigned nloc = b.st[0], nx = b.st[1];
        if (nloc == 0u) { xcd_barrier_complete(bar, b.x, nloc, nx); b.st[0] = nloc; b.st[1] = nx; }
        const unsigned old = xb_add(&bar[XB_XSUB(b.x)], 1u);
        const unsigned gen = old / nloc;
        if (old + 1u == (gen + 1u) * nloc) {
            __builtin_amdgcn_fence(__ATOMIC_RELEASE, "agent");
            asm volatile("s_waitcnt vmcnt(0)" ::: "memory");
            const unsigned og = xb_add(&bar[XB_TOP], 1u);
            const unsigned tg = og / nx;
            asm volatile("buffer_inv sc1" ::: "memory");
            if (og + 1u == (tg + 1u) * nx) xb_add(&bar[XB_TOPGEN], 1u);
            else XB_SPIN(xb_ld(&bar[XB_TOPGEN]) == tg, bar);
            xb_add(&bar[XB_XGEN(b.x)], 1u);
            asm volatile("s_waitcnt vmcnt(0)" ::: "memory");
        } else {
            asm volatile("buffer_inv sc1" ::: "memory");
            XB_SPIN(xb_ld(&bar[XB_XGEN(b.x)]) == gen, bar);
            asm volatile("s_waitcnt vmcnt(0)" ::: "memory");
        }
    }
    __syncthreads();
}

__device__ __forceinline__ int lds_byte(int r, int c) { const int st = (r >> 4) * 2 + (c >> 5), rr = r & 15, cc = c & 31, ob = rr * 64 + cc * 2; return st * 1024 + (ob ^ (((ob >> 9) & 1) << 5)); }
__device__ __forceinline__ void stage_rc(int b, int& R, int& C) { const int st = b / 1024, sb = b % 1024, swz = sb ^ (((sb >> 9) & 1) << 5); R = (st >> 1) * 16 + swz / 64; C = (st & 1) * 32 + (swz % 64) / 2; }

__device__ __forceinline__ int perm32(int rho) { const int n = rho >> 4, i = rho & 15; return 8 * (i >> 2) + 4 * n + (i & 3); }
__device__ __forceinline__ void st_bf16x8(bf16_t* p, const f32x4 a, const f32x4 b) { uint4 o; o.x = cvt_pk_bf16(a[0], a[1]); o.y = cvt_pk_bf16(a[2], a[3]); o.z = cvt_pk_bf16(b[0], b[1]); o.w = cvt_pk_bf16(b[2], b[3]); *(uint4*)p = o; }
struct Unit { int pm, pn; };
struct Gemm { const bf16_t* A; const bf16_t* Bt; int M, N, K; };
struct StaticOrder {
    int nM, nN, nwg, G, c, wgm;
    __device__ void init(int M, int N, int G_, int c_, int wgm_ = WGM) { nM = M / BM; nN = N / BM; nwg = nM * nN; G = G_; c = c_; wgm = wgm_; }
    __device__ bool next(int i, Unit& u) const {
        const long L = (long)i * G + c; if (L >= nwg) return false;
        int wgid = (int)L; { const int q = nwg / NXCD, r = nwg % NXCD, xcd = wgid % NXCD, off = wgid / NXCD; wgid = (xcd < r ? xcd * (q + 1) : r * (q + 1) + (xcd - r) * q) + off; }
        const int nig = wgm * nN, gid = wgid / nig, fm = gid * wgm, gsz = (nM - fm) < wgm ? (nM - fm) : wgm;
        u.pm = fm + ((wgid % nig) % gsz); u.pn = (wgid % nig) / gsz; return true;
    }
};

#define EPI_MAIN_CALL \
    static constexpr bool AFTER_DRAIN = false; \
    __device__ __forceinline__ void operator()(const f32x4 (&acc)[2][2][4][2], const Unit& u, int wr, int wc, int fr, int fq) const { \
        const int rowb = u.pm * BM + wr * 64 + fr; \
        _Pragma("unroll") for (int ai = 0; ai < 2; ++ai) _Pragma("unroll") for (int m = 0; m < 4; ++m) { \
            const f32x4 a[2][2] = {{acc[ai][0][m][0], acc[ai][0][m][1]}, {acc[ai][1][m][0], acc[ai][1][m][1]}}; \
            row(a, rowb + ai * HALF + m * 16, u.pn, wc, fq); } }
struct EpiIn {
    bf16_t *pU, *pV, *pBG, *pZ; const float* g_v; float* out;
    __device__ __forceinline__ void row(const f32x4 (&a)[2][2], int row, int pn, int wc, int fq) const {
        if (pn < 2 || pn == 4 || pn == 5) {
            bf16_t* dst = (pn < 2 ? pU : pBG) + (size_t)row * 512 + (pn & 1) * 256 + wc * 32 + 8 * fq;
#pragma unroll
            for (int bj = 0; bj < 2; ++bj) { f32x4 v0 = a[bj][0], v1 = a[bj][1];
                if (pn < 2) {
#pragma unroll
                    for (int j = 0; j < 4; ++j) { v0[j] = gelu_tanh(v0[j]); v1[j] = gelu_tanh(v1[j]); } }
                st_bf16x8(dst + bj * HALF, v0, v1); }
        } else if (pn < 4) {
            const int head = (pn - 2) * 4 + wc;
            f32x4 g[2][2]; float ss = 0.f;
#pragma unroll
            for (int bj = 0; bj < 2; ++bj)
#pragma unroll
                for (int n = 0; n < 2; ++n)
#pragma unroll
                    for (int j = 0; j < 4; ++j) { const float t = gelu_tanh(a[bj][n][j]); g[bj][n][j] = t; ss += t * t; }
            ss += __shfl_xor(ss, 16); ss += __shfl_xor(ss, 32);
            const float rs = rsqrtf(ss * (1.f / 64.f) + EPS);
#pragma unroll
            for (int bj = 0; bj < 2; ++bj) { const int d = head * 64 + bj * 32 + 8 * fq;
                const f32x4 v0 = g[bj][0] * rs * *(const f32x4*)(g_v + d), v1 = g[bj][1] * rs * *(const f32x4*)(g_v + d + 4);
                st_bf16x8(pV + (size_t)row * 512 + d, v0, v1);
                if (row >= NP && row < NTOK) { float* o = out + O_VS + (size_t)(row - NP) * 512 + d; *(f32x4*)o = v0; *(f32x4*)(o + 4) = v1; } }
        } else {
            const int c = (pn - 6) * 128 + wc * 32 + 8 * fq;
            const f32x4 z0 = a[0][0] * a[1][0], z1 = a[0][1] * a[1][1];
            st_bf16x8(pZ + (size_t)row * 512 + c, z0, z1);
            float* o = nullptr;
            if (row < NP) { const int t = row & 2047; if (t >= 2046) o = out + O_CONVP + (size_t)((row >> 11) * 2 + (t - 2046)) * 512 + c; }
            else if (row < NTOK) o = out + O_CONVS + (size_t)((row - NP) * 2 + 1) * 512 + c;
            if (o) { *(f32x4*)o = z0; *(f32x4*)(o + 4) = z1; }
        }
    }
    EPI_MAIN_CALL
};
struct EpiRes {
    const float *xp, *xs, *mod; float* out; int gate_off; int inplace;
    __device__ __forceinline__ void row(const f32x4 (&a)[2][2], int row, int pn, int wc, int fq) const {
        if (row < NTOK) { const int cb = pn * BM + wc * 32 + 4 * fq;
            const float* gt = mod + (size_t)batch_of(row) * NMOD + gate_off; float* orow = out + (size_t)row * DM;
            const float* br = inplace ? orow : (row < NP ? xp + (size_t)row * DM : xs + (size_t)(row - NP) * DM);
#pragma unroll
            for (int bj = 0; bj < 2; ++bj)
#pragma unroll
                for (int n = 0; n < 2; ++n) { const int c = cb + bj * HALF + n * 16;
                    *(f32x4*)(orow + c) = *(const f32x4*)(br + c) + *(const f32x4*)(gt + c) * a[bj][n]; } }
    }
    __device__ __forceinline__ void frag(const f32x4 a, int row, int cs) const {
        const int c = (cs & ~31) + perm32(cs & 31);
        const float* gt = mod + (size_t)batch_of(row) * NMOD + gate_off; float* orow = out + (size_t)row * DM;
        const float* br = inplace ? orow : (row < NP ? xp + (size_t)row * DM : xs + (size_t)(row - NP) * DM);
        *(f32x4*)(orow + c) = *(const f32x4*)(br + c) + *(const f32x4*)(gt + c) * a; }
    EPI_MAIN_CALL
};
struct EpiRelu2 {
    bf16_t* T;
    __device__ __forceinline__ void row(const f32x4 (&a)[2][2], int row, int pn, int wc, int fq) const {
        bf16_t* rp = T + (size_t)row * DFF + pn * BM + wc * 32 + 8 * fq;
#pragma unroll
        for (int bj = 0; bj < 2; ++bj) { f32x4 v0 = a[bj][0], v1 = a[bj][1];
#pragma unroll
            for (int j = 0; j < 4; ++j) { const float r0 = fmaxf(v0[j], 0.f), r1 = fmaxf(v1[j], 0.f); v0[j] = r0 * r0; v1[j] = r1 * r1; }
            st_bf16x8(rp + bj * HALF, v0, v1); }
    }
    __device__ __forceinline__ void frag(f32x4 v, int row, int c) const {
#pragma unroll
        for (int j = 0; j < 4; ++j) { const float r = fmaxf(v[j], 0.f); v[j] = r * r; }
        st_bf16x4(T + (size_t)row * DFF + (c & ~31) + perm32(c & 31), v); }
    EPI_MAIN_CALL
};
struct EpiNull {
    float* sink; int flag;
    __device__ __forceinline__ void row(const f32x4 (&a)[2][2], int row, int pn, int wc, int fq) const {
        if (flag) { *(f32x4*)(sink + (size_t)row * DM + pn * BM + wc * 32 + 4 * fq) = a[0][0] + a[0][1] + a[1][0] + a[1][1]; } }
    EPI_MAIN_CALL
};
__device__ __forceinline__ void spin_until(unsigned* p, unsigned need) { unsigned sp = 0; while (xb_ld(p) < need) { __builtin_amdgcn_s_sleep(1); if (++sp > (1u << 20)) break; } }
template <int MODE>
struct EpiFused {
    static constexpr bool AFTER_DRAIN = true;
    const float *xp, *mod, *g; float* out; bf16_t* H; float* slots; unsigned* cnt; bf16_t* X1;
    __device__ __forceinline__ void fused(f32x4 (&acc)[2][2][4][2], const Unit& u, int wr, int wc, int fr, int fq, float* smem) const {
        const int tid = fresh_tid();
        const float* mb = mod + (size_t)(u.pm >> 3) * NMOD;
        const int cb = u.pn * BM + wc * 32 + 8 * fq, rl0 = wr * 64 + fr;
        float* part = smem; float* rsv = smem + 1024;
        f32x4 gt[2][2];
#pragma unroll
        for (int bj = 0; bj < 2; ++bj)
#pragma unroll
            for (int n = 0; n < 2; ++n) gt[bj][n] = *(const f32x4*)(mb + (MODE ? 5120 : 2048) + cb + bj * HALF + n * 4);
#pragma unroll
        for (int ai = 0; ai < 2; ++ai) {
            f32x4 bs[4][2][2];
#pragma unroll
            for (int m = 0; m < 4; ++m) { const size_t ro = (size_t)(u.pm * BM + rl0 + ai * HALF + m * 16) * DM;
#pragma unroll
                for (int bj = 0; bj < 2; ++bj)
#pragma unroll
                    for (int n = 0; n < 2; ++n) { const int c = cb + bj * HALF + n * 4;
                        if (MODE) { const uint2 q = *(const uint2*)(X1 + ro + c); bs[m][bj][n] = (f32x4){bf_lo(q.x), bf_hi(q.x), bf_lo(q.y), bf_hi(q.y)}; }
                        else bs[m][bj][n] = *(const f32x4*)(xp + ro + c); } }
            __builtin_amdgcn_sched_barrier(0);
#pragma unroll
            for (int m = 0; m < 4; ++m) { float ss = 0.f;
#pragma unroll
                for (int bj = 0; bj < 2; ++bj)
#pragma unroll
                    for (int n = 0; n < 2; ++n) { const f32x4 v = bs[m][bj][n] + gt[bj][n] * acc[ai][bj][m][n]; acc[ai][bj][m][n] = v; ss += v[0] * v[0] + v[1] * v[1] + v[2] * v[2] + v[3] * v[3]; }
                ss += __shfl_xor(ss, 16); ss += __shfl_xor(ss, 32);
                if (fq == 0) part[(rl0 + ai * HALF + m * 16) * 4 + wc] = ss; } }
        __syncthreads();
        if (tid < 256) { const f32x4 q = *(const f32x4*)(part + tid * 4); __hip_atomic_store(slots + (size_t)(u.pm * 4 + u.pn) * 256 + tid, (q[0] + q[1]) + (q[2] + q[3]), __ATOMIC_RELAXED, __HIP_MEMORY_SCOPE_AGENT); }
        asm volatile("s_waitcnt vmcnt(0)" ::: "memory");
        __syncthreads();
        if (tid == 0) { xb_add(cnt + u.pm * 64, 1u); spin_until(cnt + u.pm * 64, 4u); }
        f32x4 gs[2][2], sh[2][2];
#pragma unroll
        for (int bj = 0; bj < 2; ++bj)
#pragma unroll
            for (int n = 0; n < 2; ++n) { const int c = cb + bj * HALF + n * 4; gs[bj][n] = *(const f32x4*)(g + c);
                if (MODE == 0) { gs[bj][n] = gs[bj][n] * (*(const f32x4*)(mb + 4096 + c) + 1.f); sh[bj][n] = *(const f32x4*)(mb + 3072 + c); } }
        __syncthreads();
        if (tid < 256) { float s = 0.f;
#pragma unroll
            for (int q = 0; q < 4; ++q) s += __hip_atomic_load(slots + (size_t)(u.pm * 4 + q) * 256 + tid, __ATOMIC_RELAXED, __HIP_MEMORY_SCOPE_AGENT);
            rsv[tid] = rsqrtf(s * (1.f / DM) + EPS); }
        __syncthreads();
#pragma unroll
        for (int ai = 0; ai < 2; ++ai)
#pragma unroll
            for (int m = 0; m < 4; ++m) { const int rl = rl0 + ai * HALF + m * 16; const size_t ro = (size_t)(u.pm * BM + rl) * DM; const float r = rsv[rl];
#pragma unroll
                for (int bj = 0; bj < 2; ++bj) { const int c = cb + bj * HALF; const f32x4 v0 = acc[ai][bj][m][0], v1 = acc[ai][bj][m][1];
                    if (MODE == 0) { st_bf16x8(X1 + ro + c, v0, v1); st_bf16x8(H + ro + c, v0 * r * gs[bj][0] + sh[bj][0], v1 * r * gs[bj][1] + sh[bj][1]); }
                    else { *(f32x4*)(out + ro + c) = v0 * r * gs[bj][0]; *(f32x4*)(out + ro + c + 4) = v1 * r * gs[bj][1]; } } }
        __syncthreads();
    }
};
struct EpiMod {
    float* mod; const float* b_ada;
    __device__ __forceinline__ void frag(const f32x4 a, int row, int c) const { if (row < NB) *(f32x4*)(mod + (size_t)row * NMOD + c) = a + *(const f32x4*)(b_ada + c); }
    __device__ __forceinline__ void row(const f32x4 (&a)[2][2], int row, int pn, int wc, int fq) const {
        if (row < NB) { const int cb = pn * BM + wc * 32 + 4 * fq;
#pragma unroll
            for (int bj = 0; bj < 2; ++bj)
#pragma unroll
                for (int n = 0; n < 2; ++n) { const int c = cb + bj * HALF + n * 16; *(f32x4*)(mod + (size_t)row * NMOD + c) = a[bj][n] + *(const f32x4*)(b_ada + c); } }
    }
};

template <class Epi>
__device__ __forceinline__ void small_gemm(const bf16_t* __restrict__ A, int nm16, const bf16_t* __restrict__ Bt, int N, int K, const Epi& E, int row_base, float* smem, int blk, int nblk) {
    if (blk < 0) return;
    const int tid = fresh_tid(), w = tid >> 6, lane = tid & 63, fr = lane & 15, fq = lane >> 4;
    const int ntasks = (N / 256) * 4 * nm16, kw = K / 8;
    f32x4* red = (f32x4*)smem;
    for (int t = blk; t < ntasks; t += nblk) {
        const int m16 = t % nm16, r = t / nm16, wc = r & 3, pn = r >> 2;
        const bf16_t* ap = A + (size_t)(m16 * 16 + fr) * K + w * kw + fq * 8;
        const bf16_t* bp = Bt + (size_t)(pn * 256 + wc * 32 + fr) * K + w * kw + fq * 8;
        f32x4 acc[2][2] = {{{0.f, 0.f, 0.f, 0.f}, {0.f, 0.f, 0.f, 0.f}}, {{0.f, 0.f, 0.f, 0.f}, {0.f, 0.f, 0.f, 0.f}}};
#pragma unroll 4
        for (int ks = 0; ks < kw / 32; ++ks) {
            Frag a; a.q = *(const uint4*)(ap + ks * 32);
#pragma unroll
            for (int bj = 0; bj < 2; ++bj)
#pragma unroll
                for (int n = 0; n < 2; ++n) { Frag b; b.q = *(const uint4*)(bp + (size_t)(bj * 128 + n * 16) * K + ks * 32);
                    acc[bj][n] = __builtin_amdgcn_mfma_f32_16x16x32_bf16(b.v, a.v, acc[bj][n], 0, 0, 0); }
        }
#pragma unroll
        for (int i = 0; i < 4; ++i) red[(w * 4 + i) * 64 + lane] = acc[i >> 1][i & 1];
        __syncthreads();
        if (w == 0) { f32x4 s[2][2];
#pragma unroll
            for (int i = 0; i < 4; ++i) { f32x4 v = red[i * 64 + lane];
#pragma unroll
                for (int w2 = 1; w2 < 8; ++w2) v += red[(w2 * 4 + i) * 64 + lane];
                s[i >> 1][i & 1] = v; }
            E.row(s, row_base + m16 * 16 + fr, pn, wc, fq); }
        __syncthreads();
    }
}


template <int KSPLIT, int BATCH, bool SHAREB = false, class Epi>
__device__ __forceinline__ void small_gemm_w(const bf16_t* __restrict__ A, int nm16, const bf16_t* __restrict__ Bt, int N, int K, const Epi& E, int row_base, float* smem) {
    const int tid = fresh_tid(), w = tid >> 6, lane = tid & 63, fr = lane & 15, fq = lane >> 4;
    const int total = nm16 * (N / 16) * KSPLIT, kw = K / KSPLIT;
    f32x4* red = (f32x4*)smem;
    for (int base = blockIdx.x * 8; base < total; base += gridDim.x * 8) {
        const int task = base + w; const bool valid = task < total;
        const int tile = task / KSPLIT, ks = task % KSPLIT, m16 = tile % nm16, n16 = tile / nm16;
        f32x4 acc = {0.f, 0.f, 0.f, 0.f};
        if (KSPLIT == 1 && SHAREB) {
            __syncthreads();
            uint4* Bs = (uint4*)smem; const int nst = kw / 32, per = nst / 8;
            const bf16_t* bpb = Bt + (size_t)((base / nm16) * 16 + fr) * K + fq * 8;
            for (int j = 0; j < per; ++j) { const int s = w * per + j; Bs[s * 64 + lane] = *(const uint4*)(bpb + s * 32); }
            __syncthreads();
            if (valid) {
                const bf16_t* ap = A + (size_t)(m16 * 16 + fr) * K + fq * 8;
                for (int s0 = 0; s0 < nst; s0 += BATCH) { Frag a[BATCH];
#pragma unroll
                    for (int i = 0; i < BATCH; ++i) a[i].q = *(const uint4*)(ap + (s0 + i) * 32);
                    __builtin_amdgcn_sched_barrier(0);
#pragma unroll
                    for (int i = 0; i < BATCH; ++i) { Frag b; b.q = Bs[(s0 + i) * 64 + lane]; acc = __builtin_amdgcn_mfma_f32_16x16x32_bf16(b.v, a[i].v, acc, 0, 0, 0); }
                    __builtin_amdgcn_sched_barrier(0); } }
            __syncthreads();
        } else if (valid) {
            const bf16_t* ap = A + (size_t)(m16 * 16 + fr) * K + ks * kw + fq * 8;
            const bf16_t* bp = Bt + (size_t)(n16 * 16 + fr) * K + ks * kw + fq * 8;
            for (int s0 = 0; s0 < kw / 32; s0 += BATCH) { Frag a[BATCH], b[BATCH];
#pragma unroll
                for (int i = 0; i < BATCH; ++i) { a[i].q = *(const uint4*)(ap + (s0 + i) * 32); b[i].q = *(const uint4*)(bp + (s0 + i) * 32); }
                __builtin_amdgcn_sched_barrier(0);
#pragma unroll
                for (int i = 0; i < BATCH; ++i) acc = __builtin_amdgcn_mfma_f32_16x16x32_bf16(b[i].v, a[i].v, acc, 0, 0, 0);
                __builtin_amdgcn_sched_barrier(0); }
        }
        if (KSPLIT > 1) {
            red[w * 64 + lane] = acc;
            __syncthreads();
            if (ks == 0) {
#pragma unroll
                for (int j = 1; j < KSPLIT; ++j) acc += red[(w + j) * 64 + lane]; }
        }
        if (valid && ks == 0) E.frag(acc, row_base + m16 * 16 + fr, n16 * 16 + 4 * fq);
        if (KSPLIT > 1) __syncthreads();
    }
}

template <class Epi>
__device__ __forceinline__ void gemm_phase(LAS unsigned char* lds, const Gemm g, const StaticOrder& S, const Epi& E, float* smem = nullptr) {
    const int tid = fresh_tid(), wid = __builtin_amdgcn_readfirstlane(tid >> 6), lane = tid & 63, wr = wid >> 2, wc = wid & 3, fr = lane & 15, fq = lane >> 4;
    const int K = g.K, nt = K / BK;
    unsigned voffA[2];
#pragma unroll
    for (int i = 0; i < 2; ++i) { int R, C; stage_rc(tid * 16 + i * 8192, R, C); voffA[i] = (unsigned)(R * K + C) * 2u; }
    const size_t kstep = (size_t)(BK * 2), hstep = (size_t)HALF * K * 2, tstep = 2 * hstep;
    const unsigned ldsw = (unsigned)wid * 1024u;
    const int aoff = lds_byte(wr * 64 + fr, fq * 8), boff = lds_byte(wc * 32 + fr, fq * 8);
#define PG8_SA(b, h) (((b) * 2 + (h)) * HTB)
#define PG8_SB(b, h) ((4 + (b) * 2 + (h)) * HTB)
#define PG8_STAGE(bufoff, gbase, voff) do { _Pragma("unroll") for (int _i = 0; _i < 2; ++_i) \
        __builtin_amdgcn_global_load_lds((const unsigned*)((const char*)(gbase) + (voff)[_i]), (LAS unsigned*)(lds + (bufoff) + ldsw + _i * 8192), 16, 0, 0); } while (0)
#define PG8_LDA(dst, b, h) do { _Pragma("unroll") for (int m = 0; m < 4; ++m) _Pragma("unroll") for (int k = 0; k < 2; ++k) dst[m][k] = *(const LAS bf16x8*)(lds + PG8_SA(b, h) + aoff + m * 2048 + k * 1024); } while (0)
#define PG8_LDB(dst, b, h) do { _Pragma("unroll") for (int n = 0; n < 2; ++n) _Pragma("unroll") for (int k = 0; k < 2; ++k) dst[n][k] = *(const LAS bf16x8*)(lds + PG8_SB(b, h) + boff + n * 2048 + k * 1024); } while (0)
#define PG8_MMA(ai, bj, At, Bt) do { __builtin_amdgcn_s_setprio(1); _Pragma("unroll") for (int m = 0; m < 4; ++m) _Pragma("unroll") for (int n = 0; n < 2; ++n) _Pragma("unroll") for (int k = 0; k < 2; ++k) \
        acc[ai][bj][m][n] = __builtin_amdgcn_mfma_f32_16x16x32_bf16(Bt[n][k], At[m][k], acc[ai][bj][m][n], 0, 0, 0); __builtin_amdgcn_s_setprio(0); } while (0)
#define PG8_WAIT_V(n) asm volatile("s_waitcnt vmcnt(" #n ")" ::: "memory")
#define PG8_WAIT_L(n) asm volatile("s_waitcnt lgkmcnt(" #n ")" ::: "memory")
#define PG8_BAR __builtin_amdgcn_s_barrier()
#define PG8_SCHED __builtin_amdgcn_sched_barrier(0)
    Unit cur, nxt; int ui = 0;
    if (!S.next(0, cur)) return;
    f32x4 acc[2][2][4][2];
#pragma unroll
    for (int a = 0; a < 2; ++a)
#pragma unroll
        for (int b = 0; b < 2; ++b)
#pragma unroll
            for (int m = 0; m < 4; ++m)
#pragma unroll
                for (int n = 0; n < 2; ++n) acc[a][b][m][n] = (f32x4){0.f, 0.f, 0.f, 0.f};
    bf16x8 At[4][2], B0[2][2], B1[2][2];
    const char* cA = (const char*)g.A + (size_t)cur.pm * tstep; const char* cB = (const char*)g.Bt + (size_t)cur.pn * tstep;
    PG8_STAGE(PG8_SB(0, 0), cB, voffA); PG8_STAGE(PG8_SA(0, 0), cA, voffA); PG8_STAGE(PG8_SB(0, 1), cB + hstep, voffA); PG8_STAGE(PG8_SA(0, 1), cA + hstep, voffA);
    if (wr == 1) PG8_BAR;
    PG8_WAIT_V(4); PG8_BAR;
    PG8_STAGE(PG8_SB(1, 0), cB + kstep, voffA); PG8_STAGE(PG8_SA(1, 0), cA + kstep, voffA); PG8_STAGE(PG8_SB(1, 1), cB + hstep + kstep, voffA);
    PG8_WAIT_V(6); PG8_BAR;
    for (;;) {
        const bool has_next = S.next(ui + 1, nxt);
        const char* nA = has_next ? (const char*)g.A + (size_t)nxt.pm * tstep : cA; const char* nB = has_next ? (const char*)g.Bt + (size_t)nxt.pn * tstep : cB;
        for (int t = 0; t < nt; t += 2) {
            const bool last = (t == nt - 2);
            const char* a1 = cA + (size_t)(t + 1) * kstep;
            const char* a2 = last ? nA : cA + (size_t)(t + 2) * kstep; const char* b2 = last ? nB : cB + (size_t)(t + 2) * kstep;
            const char* a3 = a2 + kstep; const char* b3 = b2 + kstep;
            PG8_LDB(B0, 0, 0); PG8_SCHED; PG8_LDA(At, 0, 0); PG8_STAGE(PG8_SA(1, 1), a1 + hstep, voffA);
            PG8_WAIT_L(8); PG8_BAR; PG8_WAIT_L(0); PG8_MMA(0, 0, At, B0); PG8_BAR; PG8_SCHED;
            PG8_LDB(B1, 0, 1); PG8_STAGE(PG8_SB(0, 0), b2, voffA);
            PG8_BAR; PG8_WAIT_L(0); PG8_MMA(0, 1, At, B1); PG8_BAR;
            PG8_LDA(At, 0, 1); PG8_STAGE(PG8_SA(0, 0), a2, voffA);
            PG8_BAR; PG8_WAIT_L(0); PG8_MMA(1, 0, At, B0); PG8_BAR; PG8_SCHED;
            PG8_STAGE(PG8_SB(0, 1), b2 + hstep, voffA);
            PG8_WAIT_V(6); PG8_BAR; PG8_MMA(1, 1, At, B1); PG8_BAR;
            PG8_LDB(B0, 1, 0); PG8_SCHED; PG8_LDA(At, 1, 0); PG8_STAGE(PG8_SA(0, 1), a2 + hstep, voffA);
            PG8_WAIT_L(8); PG8_BAR; PG8_WAIT_L(0); PG8_MMA(0, 0, At, B0); PG8_BAR; PG8_SCHED;
            PG8_LDB(B1, 1, 1); PG8_STAGE(PG8_SB(1, 0), b3, voffA);
            PG8_BAR; PG8_WAIT_L(0); PG8_MMA(0, 1, At, B1); PG8_BAR;
            PG8_LDA(At, 1, 1); PG8_STAGE(PG8_SA(1, 0), a3, voffA);
            PG8_BAR; PG8_WAIT_L(0); PG8_MMA(1, 0, At, B0); PG8_BAR; PG8_SCHED;
            PG8_STAGE(PG8_SB(1, 1), b3 + hstep, voffA);
            PG8_WAIT_V(6); PG8_BAR; PG8_MMA(1, 1, At, B1); PG8_BAR;
        }
        if constexpr (!Epi::AFTER_DRAIN) E(acc, cur, wr, wc, fr, fq);
        if (!has_next) break;
#pragma unroll
        for (int a = 0; a < 2; ++a)
#pragma unroll
            for (int b = 0; b < 2; ++b)
#pragma unroll
                for (int m = 0; m < 4; ++m)
#pragma unroll
                    for (int n = 0; n < 2; ++n) acc[a][b][m][n] = (f32x4){0.f, 0.f, 0.f, 0.f};
        cur = nxt; cA = nA; cB = nB; ++ui;
    }
    PG8_WAIT_V(0);
    if (wr == 0) PG8_BAR;
    PG8_BAR;
    if constexpr (Epi::AFTER_DRAIN) E.fused(acc, cur, wr, wc, fr, fq, smem);
#undef PG8_SA
#undef PG8_SB
#undef PG8_STAGE
#undef PG8_LDA
#undef PG8_LDB
#undef PG8_MMA
#undef PG8_WAIT_V
#undef PG8_WAIT_L
#undef PG8_BAR
#undef PG8_SCHED
}

__device__ __forceinline__ int win_src_col(int np) {
    const int tile = np >> 8, s = np & 255;
    if (tile < 2 || tile == 4 || tile == 5) return np;
    if (tile < 4) { const int bj = s >> 7, wc = (s >> 5) & 3, i = s & 31; return 512 + (tile - 2) * 256 + wc * 64 + bj * 32 + i; }
    return 1536 + (s >> 7) * 512 + (tile - 6) * 128 + (s & 127);
}
template <bool PERMW, bool PERM32>
__device__ __forceinline__ void transpose_cvt(const float* __restrict__ src, bf16_t* __restrict__ dst, int K, int N, float* T, int& tile_ctr, int blk, int nblk) {
    const int tid = fresh_tid(), nkt = K / 64, ntiles = nkt * (N / 256);
    int tl0 = (blk - tile_ctr) % nblk; if (tl0 < 0) tl0 += nblk;
    tile_ctr += ntiles;
    for (int tl = tl0; tl < ntiles; tl += nblk) {
        const int k0 = (tl % nkt) * 64, n0 = (tl / nkt) * 256;
        { const int n4 = (tid & 63) * 4, sc = PERMW ? win_src_col(n0 + n4) : n0 + n4; f32x4 v[8];
#pragma unroll
          for (int i = 0; i < 8; ++i) { const int k = (tid >> 6) + 8 * i; v[i] = *(const f32x4*)(src + (size_t)(k0 + k) * N + sc); }
#pragma unroll
          for (int i = 0; i < 8; ++i) { const int k = (tid >> 6) + 8 * i; *(f32x4*)(T + k * 256 + (n4 ^ (((k >> 3) & 7) << 2))) = v[i]; } }
        __syncthreads();
#pragma unroll
        for (int i = 0; i < 4; ++i) { const int pi = tid + 512 * i, q = pi & 7, nl = pi >> 3, x = PERM32 ? (nl & ~31) + perm32(nl & 31) : nl; const float* tp = T + (8 * q) * 256 + (x ^ (q << 2)); uint4 o;
            o.x = cvt_pk_bf16(tp[0], tp[256]); o.y = cvt_pk_bf16(tp[512], tp[768]); o.z = cvt_pk_bf16(tp[1024], tp[1280]); o.w = cvt_pk_bf16(tp[1536], tp[1792]);
            *(uint4*)(dst + (size_t)(n0 + nl) * K + k0 + 8 * q) = o; }
        __syncthreads();
    }
}
__device__ __forceinline__ void mod_phase(const Params& p, const bf16_t* __restrict__ Sb, float* smem) {
    const int tid = fresh_tid(), w = tid >> 6, lane = tid & 63, fr = lane & 15, fq = lane >> 4;
    f32x4* red = (f32x4*)smem; float* mod = (float*)(p.ws + WS_MOD);
    for (int it = blockIdx.x; it < NMOD / 32; it += gridDim.x) {
        const int col0 = it * 32;
        f32x4 acc[2][9];
#pragma unroll
        for (int i = 0; i < 9; ++i) { acc[0][i] = (f32x4){0.f, 0.f, 0.f, 0.f}; acc[1][i] = (f32x4){0.f, 0.f, 0.f, 0.f}; }
        Frag wfA[4], wfB[4];
#pragma unroll
        for (int kk = 0; kk < 4; ++kk) { const float* wp = p.w_ada + (size_t)(w * 128 + kk * 32 + fq * 8) * NMOD + col0 + 2 * fr;
#pragma unroll
            for (int i = 0; i < 4; ++i) { const float2 v0 = *(const float2*)(wp + (size_t)(2 * i) * NMOD), v1 = *(const float2*)(wp + (size_t)(2 * i + 1) * NMOD);
                wfA[kk].u[i] = cvt_pk_bf16(v0.x, v1.x); wfB[kk].u[i] = cvt_pk_bf16(v0.y, v1.y); } }
#pragma unroll
        for (int kk = 0; kk < 4; ++kk) {
#pragma unroll
            for (int bt = 0; bt < 9; ++bt) { Frag sf; sf.q = *(const uint4*)(Sb + (size_t)(bt * 16 + fr) * DM + w * 128 + kk * 32 + fq * 8);
                acc[0][bt] = __builtin_amdgcn_mfma_f32_16x16x32_bf16(wfA[kk].v, sf.v, acc[0][bt], 0, 0, 0);
                acc[1][bt] = __builtin_amdgcn_mfma_f32_16x16x32_bf16(wfB[kk].v, sf.v, acc[1][bt], 0, 0, 0); } }
        if (w >= 4) {
#pragma unroll
            for (int bt = 0; bt < 9; ++bt) { red[((w - 4) * 18 + bt) * 64 + lane] = acc[0][bt]; red[((w - 4) * 18 + 9 + bt) * 64 + lane] = acc[1][bt]; } }
        __syncthreads();
        if (w < 4) {
#pragma unroll
            for (int bt = 0; bt < 9; ++bt) { acc[0][bt] += red[(w * 18 + bt) * 64 + lane]; acc[1][bt] += red[(w * 18 + 9 + bt) * 64 + lane]; } }
        __syncthreads();
        if (w < 4) {
#pragma unroll
            for (int bt = 0; bt < 9; ++bt) { red[(w * 18 + bt) * 64 + lane] = acc[0][bt]; red[(w * 18 + 9 + bt) * 64 + lane] = acc[1][bt]; } }
        __syncthreads();
        for (int idx = tid; idx < 9 * 64; idx += 512) { const int bt = idx >> 6, l = idx & 63; f32x4 sa = red[bt * 64 + l], sb = red[(9 + bt) * 64 + l];
#pragma unroll
            for (int w2 = 1; w2 < 4; ++w2) { sa += red[(w2 * 18 + bt) * 64 + l]; sb += red[(w2 * 18 + 9 + bt) * 64 + l]; }
            const int b = bt * 16 + (l & 15), j = col0 + (l >> 4) * 8;
            if (b < NB) { float* mp = mod + (size_t)b * NMOD + j;
                *(f32x4*)mp = (f32x4){sa[0], sb[0], sa[1], sb[1]} + *(const f32x4*)(p.b_ada + j);
                *(f32x4*)(mp + 4) = (f32x4){sa[2], sb[2], sa[3], sb[3]} + *(const f32x4*)(p.b_ada + j + 4); } }
        __syncthreads();
    }
}
template <bool FINAL>
__device__ __forceinline__ void rownorm_phase(const Params& p, const float* g, int sh_off, int sc_off, bool from_out, int r0 = 0, int r1 = NTOK, int nblk = 0) {
    const int tid = fresh_tid(), lane = tid & 63, gw = blockIdx.x * 8 + (tid >> 6), nw = (nblk ? nblk : (int)gridDim.x) * 8;
    const float* mod = (const float*)(p.ws + WS_MOD); bf16_t* H = (bf16_t*)(p.ws + WS_H);
    f32x4 gv[4];
#pragma unroll
    for (int i = 0; i < 4; ++i) gv[i] = *(const f32x4*)(g + (i >> 1) * 512 + lane * 8 + (i & 1) * 4);
    for (int rowb = r0 + gw; rowb < r1; rowb += 4 * nw) {
        f32x4 v[4][4];
#pragma unroll
        for (int q = 0; q < 4; ++q) { const int row = rowb + q * nw;
            if (row < r1) { const float* src = from_out ? p.out + (size_t)row * DM : (row < NP ? p.x_prompt + (size_t)row * DM : p.x_sample + (size_t)(row - NP) * DM);
#pragma unroll
                for (int i = 0; i < 4; ++i) v[q][i] = *(const f32x4*)(src + (i >> 1) * 512 + lane * 8 + (i & 1) * 4); }
            else {
#pragma unroll
                for (int i = 0; i < 4; ++i) v[q][i] = (f32x4){0.f, 0.f, 0.f, 0.f}; } }
        __builtin_amdgcn_sched_barrier(0);
        float rs[4];
#pragma unroll
        for (int q = 0; q < 4; ++q) { float ss = 0.f;
#pragma unroll
            for (int i = 0; i < 4; ++i) ss += v[q][i][0] * v[q][i][0] + v[q][i][1] * v[q][i][1] + v[q][i][2] * v[q][i][2] + v[q][i][3] * v[q][i][3];
#pragma unroll
            for (int o = 1; o < 64; o <<= 1) ss += __shfl_xor(ss, o);
            rs[q] = rsqrtf(ss * (1.f / DM) + EPS); }
#pragma unroll
        for (int q = 0; q < 4; ++q) { const int row = rowb + q * nw;
            if (row < r1) { const float* mb = mod + (size_t)batch_of(row) * NMOD;
#pragma unroll
                for (int h = 0; h < 2; ++h) { const int c = h * 512 + lane * 8;
                    const f32x4 y0 = v[q][2 * h] * rs[q] * gv[2 * h], y1 = v[q][2 * h + 1] * rs[q] * gv[2 * h + 1];
                    if (FINAL) { *(f32x4*)(p.out + (size_t)row * DM + c) = y0; *(f32x4*)(p.out + (size_t)row * DM + c + 4) = y1; }
                    else st_bf16x8(H + (size_t)row * DM + c, y0 * (*(const f32x4*)(mb + sc_off + c) + 1.f) + *(const f32x4*)(mb + sh_off + c),
                                                             y1 * (*(const f32x4*)(mb + sc_off + c + 4) + 1.f) + *(const f32x4*)(mb + sh_off + c + 4)); } } }
    }
}
__device__ __forceinline__ void p1_prompt_rows(const Params& p) {
    const int tid = fresh_tid(), lane = tid & 63, gw = blockIdx.x * 8 + (tid >> 6);
    const float* mb = (const float*)(p.ws + WS_MOD) + (size_t)(gw >> 8) * NMOD; bf16_t* H = (bf16_t*)(p.ws + WS_H);
    f32x4 gs[4], sh[4];
#pragma unroll
    for (int i = 0; i < 4; ++i) { const int c = (i >> 1) * 512 + lane * 8 + (i & 1) * 4; gs[i] = *(const f32x4*)(p.g_mix + c) * (*(const f32x4*)(mb + 1024 + c) + 1.f); sh[i] = *(const f32x4*)(mb + c); }
#pragma unroll
    for (int trip = 0; trip < 2; ++trip) { const int rowb = gw * 8 + trip * 4;
        f32x4 v[4][4];
#pragma unroll
        for (int q = 0; q < 4; ++q)
#pragma unroll
            for (int i = 0; i < 4; ++i) v[q][i] = *(const f32x4*)(p.x_prompt + (size_t)(rowb + q) * DM + (i >> 1) * 512 + lane * 8 + (i & 1) * 4);
        __builtin_amdgcn_sched_barrier(0);
#pragma unroll
        for (int q = 0; q < 4; ++q) { float ss = 0.f;
#pragma unroll
            for (int i = 0; i < 4; ++i) ss += v[q][i][0] * v[q][i][0] + v[q][i][1] * v[q][i][1] + v[q][i][2] * v[q][i][2] + v[q][i][3] * v[q][i][3];
#pragma unroll
            for (int o = 1; o < 64; o <<= 1) ss += __shfl_xor(ss, o);
            const float rs = rsqrtf(ss * (1.f / DM) + EPS);
#pragma unroll
            for (int h = 0; h < 2; ++h) st_bf16x8(H + (size_t)(rowb + q) * DM + h * 512 + lane * 8, v[q][2 * h] * rs * gs[2 * h] + sh[2 * h], v[q][2 * h + 1] * rs * gs[2 * h + 1] + sh[2 * h + 1]); }
    }
}
__device__ __forceinline__ void mixer_phase(const Params& p, unsigned char* smem) {
    const int tid = fresh_tid(), w = tid >> 6, lane = tid & 63, fr = lane & 15, fq = lane >> 4;
    const bf16_t* pU = (const bf16_t*)(p.ws + WS_PU); const bf16_t* pV = (const bf16_t*)(p.ws + WS_PV); const bf16_t* pBG = (const bf16_t*)(p.ws + WS_PBG); const bf16_t* pZ = (const bf16_t*)(p.ws + WS_PZ);
    bf16_t* mA = (bf16_t*)(p.ws + WS_MA); const bf16_t* Wt = (const bf16_t*)(p.ws + WS_WTRIL);
    bf16_t* Vs = (bf16_t*)smem;
    for (int item = blockIdx.x; item < 256; item += gridDim.x) {
        const int hh = item & 1, bc = item >> 1, row0 = (bc >> 4) * 2048 + (bc & 15) * 128;
#pragma unroll
        for (int i = 0; i < 8; ++i) { const int pi = tid + 512 * i, s = pi >> 5, c16 = pi & 31, hl = c16 >> 3, d = (c16 & 7) * 8;
            *(uint4*)(Vs + ((hl * 128 + s) * 72 + d)) = *(const uint4*)(pV + (size_t)(row0 + s) * 512 + hh * 256 + c16 * 8); }
        __syncthreads();
        const int hl = w >> 1, thalf = w & 1, head = hh * 4 + hl;
        f32x4 acc[4][4];
#pragma unroll
        for (int a = 0; a < 4; ++a)
#pragma unroll
            for (int b = 0; b < 4; ++b) acc[a][b] = (f32x4){0.f, 0.f, 0.f, 0.f};
#pragma unroll
        for (int ks = 0; ks < 4; ++ks) {
            if (ks < 2 + 2 * thalf) {
                Frag af[4];
#pragma unroll
                for (int mt = 0; mt < 4; ++mt) af[mt].q = *(const uint4*)(Wt + ((size_t)(head * 128 + thalf * 64 + mt * 16 + fr) * 128 + ks * 32 + fq * 8));
#pragma unroll
                for (int nt = 0; nt < 4; ++nt) { Frag bf; const bf16_t* vp = Vs + ((hl * 128 + ks * 32 + fq * 8) * 72 + (nt >> 1) * 32 + perm32((nt & 1) * 16 + fr));
#pragma unroll
                    for (int i = 0; i < 4; ++i) bf.u[i] = (unsigned)vp[(2 * i) * 72] | ((unsigned)vp[(2 * i + 1) * 72] << 16);
#pragma unroll
                    for (int mt = 0; mt < 4; ++mt) acc[mt][nt] = __builtin_amdgcn_mfma_f32_16x16x32_bf16(bf.v, af[mt].v, acc[mt][nt], 0, 0, 0); }
            }
        }
#pragma unroll
        for (int mt = 0; mt < 4; ++mt) { const int t = thalf * 64 + mt * 16 + fr, row = row0 + t; const float bias = p.b_s[head * 128 + t];
#pragma unroll
            for (int pp = 0; pp < 2; ++pp) { const int col = head * 64 + pp * 32 + fq * 8; float u[8]; unpack8(*(const uint4*)(pU + (size_t)row * 512 + col), u);
                f32x4 o0 = acc[mt][2 * pp] + bias, o1 = acc[mt][2 * pp + 1] + bias;
#pragma unroll
                for (int j = 0; j < 4; ++j) { o0[j] *= u[j]; o1[j] *= u[4 + j]; }
                st_bf16x8(mA + (size_t)row * DM + col, o0, o1); } }
        __syncthreads();
    }
    for (int idx = blockIdx.x * 512 + tid; idx < (NP / 8) * 64; idx += gridDim.x * 512) {
        const int row0 = (idx >> 6) * 8, c = (idx & 63) * 8, t0 = row0 & 2047;
        uint4 zq[10], bq[8];
#pragma unroll
        for (int i = 0; i < 10; ++i) { zq[i] = make_uint4(0u, 0u, 0u, 0u); if (i >= 2 || t0 > 0) zq[i] = *(const uint4*)(pZ + (size_t)(row0 + i - 2) * 512 + c); }
#pragma unroll
        for (int i = 0; i < 8; ++i) bq[i] = *(const uint4*)(pBG + (size_t)(row0 + i) * 512 + c);
        float w0[8], w1[8], w2[8];
#pragma unroll
        for (int j = 0; j < 8; ++j) { w0[j] = p.w_conv[c + j]; w1[j] = p.w_conv[512 + c + j]; w2[j] = p.w_conv[1024 + c + j]; }
#pragma unroll
        for (int i = 0; i < 8; ++i) { float za[8], zb[8], zc[8], bg[8], y[8];
            unpack8(zq[i], za); unpack8(zq[i + 1], zb); unpack8(zq[i + 2], zc); unpack8(bq[i], bg);
#pragma unroll
            for (int j = 0; j < 8; ++j) y[j] = bg[j] * (w0[j] * za[j] + w1[j] * zb[j] + w2[j] * zc[j]);
            uint4 o; o.x = cvt_pk_bf16(y[0], y[1]); o.y = cvt_pk_bf16(y[2], y[3]); o.z = cvt_pk_bf16(y[4], y[5]); o.w = cvt_pk_bf16(y[6], y[7]);
            *(uint4*)(mA + (size_t)(row0 + i) * DM + 512 + c) = o; }
    }
    for (int idx = blockIdx.x * 512 + tid; idx < 128 * 64; idx += gridDim.x * 512) {
        const int i = idx >> 6, row = NP + i, c = (idx & 63) * 8;
        float z[8], bg[8], z1[8], z2[8], y[8], u[8], v[8];
        unpack8(*(const uint4*)(pZ + (size_t)row * 512 + c), z); unpack8(*(const uint4*)(pBG + (size_t)row * 512 + c), bg);
        unpack8(*(const uint4*)(pU + (size_t)row * 512 + c), u); unpack8(*(const uint4*)(pV + (size_t)row * 512 + c), v);
        const float* sp = p.state_conv + (size_t)i * 1024 + c;
#pragma unroll
        for (int j = 0; j < 8; ++j) { z2[j] = sp[j]; z1[j] = sp[512 + j]; }
        float* oc = p.out + O_CONVS + (size_t)i * 1024 + c;
        *(f32x4*)oc = (f32x4){z1[0], z1[1], z1[2], z1[3]}; *(f32x4*)(oc + 4) = (f32x4){z1[4], z1[5], z1[6], z1[7]};
        const int h = c >> 6; const float w00 = p.w_s[(size_t)h * 128 * 128], b0 = p.b_s[h * 128];
        uint4 o; o.x = cvt_pk_bf16(u[0] * (w00 * v[0] + b0), u[1] * (w00 * v[1] + b0)); o.y = cvt_pk_bf16(u[2] * (w00 * v[2] + b0), u[3] * (w00 * v[3] + b0));
        o.z = cvt_pk_bf16(u[4] * (w00 * v[4] + b0), u[5] * (w00 * v[5] + b0)); o.w = cvt_pk_bf16(u[6] * (w00 * v[6] + b0), u[7] * (w00 * v[7] + b0));
        *(uint4*)(mA + (size_t)row * DM + c) = o;
#pragma unroll
        for (int j = 0; j < 8; ++j) y[j] = bg[j] * (p.w_conv[c + j] * z2[j] + p.w_conv[512 + c + j] * z1[j] + p.w_conv[1024 + c + j] * z[j]);
        o.x = cvt_pk_bf16(y[0], y[1]); o.y = cvt_pk_bf16(y[2], y[3]); o.z = cvt_pk_bf16(y[4], y[5]); o.w = cvt_pk_bf16(y[6], y[7]);
        *(uint4*)(mA + (size_t)row * DM + 512 + c) = o;
    }
}

__global__ __launch_bounds__(512, 2) void fwd_megakernel(Params p) {
    extern __shared__ __attribute__((aligned(16))) unsigned char shm[];
    __shared__ uint4 xb_words;
    cg::grid_group grid = cg::this_grid();
    LAS unsigned char* lds = (LAS unsigned char*)shm;
    const int tid = fresh_tid(), G = gridDim.x, bid = blockIdx.x;
    if (tid == 0) xb_words = make_uint4(0u, 0u, 0u, 0u);
    __syncthreads();
    const XcdBarrier xb = xcd_barrier_post((unsigned*)(p.ws + WS_BAR), (volatile LAS unsigned*)&xb_words);
    bf16_t* WinT = (bf16_t*)(p.ws + WS_WIN); bf16_t* WoutT = (bf16_t*)(p.ws + WS_WOUT); bf16_t* Wff1T = (bf16_t*)(p.ws + WS_WFF1); bf16_t* Wff2T = (bf16_t*)(p.ws + WS_WFF2);
    bf16_t* WadaT = (bf16_t*)(p.ws + WS_WADA); bf16_t* Sb = (bf16_t*)(p.ws + WS_S);
    bf16_t* H = (bf16_t*)(p.ws + WS_H); bf16_t* mA = (bf16_t*)(p.ws + WS_MA); bf16_t* T = (bf16_t*)(p.ws + WS_R);
    float* mod = (float*)(p.ws + WS_MOD);
    for (int rep = 0; rep < ((DUP >> 0) & 1) + 1; ++rep) {
    { int ctr = 0;
      transpose_cvt<true, true>(p.w_in, WinT, DM, DIN, (float*)shm, ctr, bid, G);
      transpose_cvt<false, true>(p.w_out, WoutT, DM, DM, (float*)shm, ctr, bid, G);
      transpose_cvt<false, true>(p.w_ff2, Wff2T, DFF, DM, (float*)shm, ctr, bid, G);
      transpose_cvt<false, true>(p.w_ff1, Wff1T, DM, DFF, (float*)shm, ctr, bid, G);
      for (int i = bid * 512 + tid; i < 144 * DM / 8; i += G * 512) { const int b = i >> 7, k = (i & 127) * 8; uint4 o = {0u, 0u, 0u, 0u};
          if (b < NB) { const float* cp = (b < 8 ? p.c_prompt + (size_t)b * DM : p.c_sample + (size_t)(b - 8) * DM) + k; const f32x4 c0 = *(const f32x4*)cp, c1 = *(const f32x4*)(cp + 4);
              o.x = cvt_pk_bf16(silu_f(c0[0]), silu_f(c0[1])); o.y = cvt_pk_bf16(silu_f(c0[2]), silu_f(c0[3])); o.z = cvt_pk_bf16(silu_f(c1[0]), silu_f(c1[1])); o.w = cvt_pk_bf16(silu_f(c1[2]), silu_f(c1[3])); }
          *(uint4*)(Sb + (size_t)b * DM + k) = o; }
      bf16_t* Wt = (bf16_t*)(p.ws + WS_WTRIL);
      for (int i = bid * 512 + tid; i < 8 * 128 * 128; i += G * 512) { const int t = (i >> 7) & 127, s = i & 127; Wt[i] = (bf16_t)(cvt_pk_bf16(s <= t ? p.w_s[i] : 0.f, 0.f) & 0xffffu); } }
    }
    if (p.use_cg_sync) grid.sync();
    xcd_barrier(xb);
    for (int rep = 0; rep < ((DUP >> 1) & 1) + 1; ++rep) {
    mod_phase(p, Sb, (float*)shm);
    }
    xcd_barrier(xb);
    for (int rep = 0; rep < ((DUP >> 2) & 1) + 1; ++rep) {
    p1_prompt_rows(p);
    rownorm_phase<false>(p, p.g_mix, 0, 1024, false, NP, NTOK);
    }
    xcd_barrier(xb);
    { StaticOrder S; S.init(NP, DIN, G, bid, WGM_G1); Gemm g{H, WinT, NP, DIN, DM};
      EpiIn E{(bf16_t*)(p.ws + WS_PU), (bf16_t*)(p.ws + WS_PV), (bf16_t*)(p.ws + WS_PBG), (bf16_t*)(p.ws + WS_PZ), p.g_v, p.out};
      gemm_phase(lds, g, S, E);
      if (DUP & 8) gemm_phase(lds, g, S, E);
      small_gemm(H + (size_t)NP * DM, 8, WinT, DIN, DM, E, NP, (float*)shm, G == 256 ? bid - 128 : bid, G == 256 ? 128 : G);
      { const int blk = G == 256 ? bid - 128 : bid, nblk = G == 256 ? 128 : G;
        if (blk >= 0) { int ctr = 0;

 } } }
    xcd_barrier(xb);
    for (int rep = 0; rep < ((DUP >> 4) & 1) + 1; ++rep) {
    mixer_phase(p, shm);
    }
    xcd_barrier(xb);
    { StaticOrder S; S.init(NP, DM, G, bid); Gemm g{mA, WoutT, NP, DM, DM};
      EpiRes E{p.x_prompt, p.x_sample, mod, p.out, 2048, 0};
#if FUSE4
      EpiFused<0> EF{p.x_prompt, mod, p.g_ffn, p.out, H, (float*)(p.ws + WS_SLOT), (unsigned*)(p.ws + WS_CNT) + CNT_P4 * 64, (bf16_t*)(p.ws + WS_X1B)};
      gemm_phase(lds, g, S, EF, (float*)shm);
#else
      gemm_phase(lds, g, S, E);
#endif
      small_gemm_w<4, 8>(mA + (size_t)NP * DM, 8, WoutT, DM, DM, E, NP, (float*)shm); }
    xcd_barrier(xb);
#if !FUSE4
    rownorm_phase<false>(p, p.g_ffn, 3072, 4096, true);
    xcd_barrier(xb);
#endif
    { unsigned* ready6 = (unsigned*)(p.ws + WS_CNT) + CNT_READY6 * 64;
#if FUSE4
      if (bid < 16) {
          rownorm_phase<false>(p, p.g_ffn, 3072, 4096, true, NP, NTOK, 16);
          asm volatile("s_waitcnt vmcnt(0)" ::: "memory"); __syncthreads();
          if (fresh_tid() == 0) { __builtin_amdgcn_fence(__ATOMIC_RELEASE, "agent"); asm volatile("s_waitcnt vmcnt(0)" ::: "memory"); xb_add(ready6, 1u); } }
#endif
      StaticOrder S; S.init(NP, DFF, G, bid, WGM_G3); Gemm g{H, Wff1T, NP, DFF, DM};
      EpiRelu2 E{T};
      gemm_phase(lds, g, S, E);
#if FUSE4
      if (fresh_tid() == 0) { asm volatile("buffer_inv sc1" ::: "memory"); spin_until(ready6, 16u); asm volatile("s_waitcnt vmcnt(0)" ::: "memory"); }
      __syncthreads();
#endif
      small_gemm_w<1, 16, true>(H + (size_t)NP * DM, 8, Wff1T, DFF, DM, E, NP, (float*)shm); }
    xcd_barrier(xb);
    { unsigned* done7 = (unsigned*)(p.ws + WS_CNT) + CNT_DONE7 * 64;
      StaticOrder S; S.init(NP, DM, G, bid); Gemm g{T, Wff2T, NP, DM, DFF};
      EpiRes E{p.x_prompt, p.x_sample, mod, p.out, 5120, 1};
#if FUSE7
      small_gemm_w<4, 16>(T + (size_t)NP * DFF, 8, Wff2T, DM, DFF, E, NP, (float*)shm);
      asm volatile("s_waitcnt vmcnt(0)" ::: "memory"); __syncthreads();
      if (fresh_tid() == 0) { __builtin_amdgcn_fence(__ATOMIC_RELEASE, "agent"); asm volatile("s_waitcnt vmcnt(0)" ::: "memory"); xb_add(done7, 1u); }
      EpiFused<1> EF{p.x_prompt, mod, p.g_final, p.out, H, (float*)(p.ws + WS_SLOT) + 64 * 4 * 256, (unsigned*)(p.ws + WS_CNT) + CNT_P7 * 64, (bf16_t*)(p.ws + WS_X1B)};
      gemm_phase(lds, g, S, EF, (float*)shm);
      if (bid < 16) {
          if (fresh_tid() == 0) { asm volatile("buffer_inv sc1" ::: "memory"); spin_until(done7, (unsigned)G); asm volatile("s_waitcnt vmcnt(0)" ::: "memory"); }
          __syncthreads();
          rownorm_phase<true>(p, p.g_final, 0, 0, true, NP, NTOK, 16); }
#else
      gemm_phase(lds, g, S, E);
      small_gemm_w<4, 16>(T + (size_t)NP * DFF, 8, Wff2T, DM, DFF, E, NP, (float*)shm);
#endif
    }
#if !FUSE7
    xcd_barrier(xb);
    rownorm_phase<true>(p, p.g_final, 0, 0, true);
#endif
}

extern "C" void kernel_launch(void* const* d_in, const int* in_sizes, int n_in, void* d_out, int out_size, void* d_ws, size_t ws_size, hipStream_t stream) {
    static int grid = 0;
    if (grid == 0) {
        if (n_in != 18 || in_sizes[0] != NP * DM || (size_t)out_size != O_END || ws_size < WS_END) {
            fprintf(stderr, "kernel_launch: unexpected shapes (n_in %d, in0 %d, out %d, ws %zu, need %zu)\n", n_in, n_in > 0 ? in_sizes[0] : -1, out_size, ws_size, (size_t)WS_END); grid = -1; return; }
        int dev = 0, cus = 0, per_cu = 0;
        (void)hipGetDevice(&dev); (void)hipDeviceGetAttribute(&cus, hipDeviceAttributeMultiprocessorCount, dev);
        if (hipFuncSetAttribute((const void*)fwd_megakernel, hipFuncAttributeMaxDynamicSharedMemorySize, LDS_BYTES) != hipSuccess) { fprintf(stderr, "kernel_launch: hipFuncSetAttribute failed\n"); grid = -1; return; }
        if (hipOccupancyMaxActiveBlocksPerMultiprocessor(&per_cu, (const void*)fwd_megakernel, 512, LDS_BYTES) != hipSuccess || per_cu < 1) { fprintf(stderr, "kernel_launch: occupancy query failed (%d)\n", per_cu); grid = -1; return; }
        grid = cus * per_cu;
        if (grid != 256) { fprintf(stderr, "kernel_launch: built for 256 co-resident workgroups, got %d\n", grid); grid = -1; return; }
    }
    if (grid < 0) return;
    Params p{};
    p.x_prompt = (const float*)d_in[0]; p.x_sample = (const float*)d_in[1]; p.c_prompt = (const float*)d_in[2]; p.c_sample = (const float*)d_in[3]; p.state_conv = (const float*)d_in[4];
    p.g_mix = (const float*)d_in[5]; p.w_ada = (const float*)d_in[6]; p.b_ada = (const float*)d_in[7]; p.w_in = (const float*)d_in[8]; p.g_v = (const float*)d_in[9];
    p.w_s = (const float*)d_in[10]; p.b_s = (const float*)d_in[11]; p.w_conv = (const float*)d_in[12]; p.w_out = (const float*)d_in[13]; p.g_ffn = (const float*)d_in[14];
    p.w_ff1 = (const float*)d_in[15]; p.w_ff2 = (const float*)d_in[16]; p.g_final = (const float*)d_in[17];
    p.out = (float*)d_out; p.ws = (unsigned char*)d_ws;
    if (hipMemsetAsync((char*)d_ws + WS_BAR, 0, 16384 + CNT_BYTES, stream) != hipSuccess) { fprintf(stderr, "kernel_launch: memset failed\n"); return; }
    void* args[] = {&p};
    hipError_t e = hipLaunchCooperativeKernel((const void*)fwd_megakernel, dim3(grid), dim3(512), args, LDS_BYTES, stream);
    if (e != hipSuccess) fprintf(stderr, "cooperative launch failed: %s (grid %d)\n", hipGetErrorString(e), grid);
}
```

```cpp
#include <hip/hip_runtime.h>
#include <hip/hip_cooperative_groups.h>
#include <cstdio>
namespace cg = cooperative_groups;

#define LAS __attribute__((address_space(3)))
typedef unsigned short bf16_t;
typedef short bf16x8 __attribute__((ext_vector_type(8)));
typedef float f32x4 __attribute__((ext_vector_type(4)));

constexpr int DM = 1024, NP = 16384, NTOK = 16512, MPAD = 16640, NB = 136, NMOD = 6144, DIN = 2560, DFF = 4096;
constexpr int BM = 256, BK = 64, HALF = 128, HTB = HALF * BK * 2, STAGE_BYTES = 8 * HTB, NXCD = 8, WGM = 4;
constexpr int LDS_BYTES = STAGE_BYTES;
constexpr float EPS = 1e-6f;
#define WGM_G1 8
#define WGM_G3 4
#define DUP 0

constexpr size_t WS_WIN = 0;
constexpr size_t WS_WOUT = WS_WIN + (size_t)DIN * DM * 2;
constexpr size_t WS_WFF1 = WS_WOUT + (size_t)DM * DM * 2;
constexpr size_t WS_WFF2 = WS_WFF1 + (size_t)DFF * DM * 2;
constexpr size_t WS_WTRIL = WS_WFF2 + (size_t)DM * DFF * 2;
constexpr size_t WS_MOD = WS_WTRIL + (size_t)8 * 128 * 128 * 2;
constexpr size_t WS_H = WS_MOD + (size_t)NB * NMOD * 4;
constexpr size_t WS_R = WS_H + (size_t)MPAD * DM * 2;
constexpr size_t WS_PU = WS_R;
constexpr size_t WS_PV = WS_PU + (size_t)MPAD * 512 * 2;
constexpr size_t WS_PBG = WS_PV + (size_t)MPAD * 512 * 2;
constexpr size_t WS_PZ = WS_PBG + (size_t)MPAD * 512 * 2;
constexpr size_t WS_MA = WS_PZ + (size_t)MPAD * 512 * 2;
constexpr size_t WS_WADA = WS_R + (size_t)MPAD * DFF * 2;
constexpr size_t WS_S = WS_WADA + (size_t)NMOD * DM * 2;
constexpr size_t WS_BAR = WS_S + (size_t)144 * DM * 2;
constexpr size_t WS_CNT = WS_BAR + 16384;
constexpr int CNT_BYTES = 36864, CNT_P4 = 0, CNT_P7 = 64, CNT_READY6 = 128, CNT_DONE7 = 129, CNT_S = 130;
constexpr size_t WS_SLOT = WS_CNT + CNT_BYTES;
constexpr size_t WS_X1B = WS_SLOT + (size_t)2 * 64 * 4 * 256 * 4;
constexpr size_t WS_END = WS_X1B + (size_t)NP * DM * 2;
#define FUSE4 1
#define FUSE7 1
constexpr size_t O_Y = 0, O_CONVP = (size_t)NTOK * DM, O_CONVS = O_CONVP + 8 * 2 * 512, O_VS = O_CONVS + 128 * 2 * 512, O_END = O_VS + 128 * 512;

struct Params {
    const float *x_prompt, *x_sample, *c_prompt, *c_sample, *state_conv, *g_mix, *w_ada, *b_ada, *w_in, *g_v, *w_s, *b_s, *w_conv, *w_out, *g_ffn, *w_ff1, *w_ff2, *g_final;
    float* out; unsigned char* ws; int use_cg_sync; int pad0;
};

__device__ __forceinline__ unsigned cvt_pk_bf16(float lo, float hi) { unsigned r; asm("v_cvt_pk_bf16_f32 %0, %1, %2" : "=v"(r) : "v"(lo), "v"(hi)); return r; }
__device__ __forceinline__ float bf_lo(unsigned u) { return __uint_as_float(u << 16); }
__device__ __forceinline__ float bf_hi(unsigned u) { return __uint_as_float(u & 0xffff0000u); }
__device__ __forceinline__ float gelu_tanh(float x) { const float u = 1.5957691216f * (x + 0.044715f * x * x * x); return x * __builtin_amdgcn_rcpf(1.f + __expf(-u)); }
__device__ __forceinline__ float silu_f(float x) { return x * __builtin_amdgcn_rcpf(1.f + __expf(-x)); }
__device__ __forceinline__ void st_bf16x4(bf16_t* p, f32x4 v) { uint2 o; o.x = cvt_pk_bf16(v[0], v[1]); o.y = cvt_pk_bf16(v[2], v[3]); *(uint2*)p = o; }
__device__ __forceinline__ int batch_of(int row) { return row < NP ? (row >> 11) : (row < NTOK ? 8 + row - NP : NB - 1); }
union Frag { bf16x8 v; unsigned u[4]; uint4 q; };
__device__ __forceinline__ void unpack8(const uint4 q, float (&f)[8]) { f[0] = bf_lo(q.x); f[1] = bf_hi(q.x); f[2] = bf_lo(q.y); f[3] = bf_hi(q.y); f[4] = bf_lo(q.z); f[5] = bf_hi(q.z); f[6] = bf_lo(q.w); f[7] = bf_hi(q.w); }
__device__ __forceinline__ int fresh_tid() { int t = threadIdx.x; asm volatile("" : "+v"(t)); return t; }


#define XB_TMO      128
#define XB_XCNT(j)  (256  + 64 * (j))
#define XB_XSUB(j)  (1280 + 64 * (j))
#define XB_XGEN(j)  (2304 + 64 * (j))
#define XB_TOP      3328
#define XB_TOPGEN   3392
#define XCD_BAR_WORDS 3456
#define XB_SPIN_CAP (1u << 18)
__device__ __forceinline__ unsigned xb_ld(unsigned* p)              { return __hip_atomic_load(p, __ATOMIC_RELAXED, __HIP_MEMORY_SCOPE_AGENT); }
__device__ __forceinline__ unsigned xb_add(unsigned* p, unsigned v) { return __hip_atomic_fetch_add(p, v, __ATOMIC_RELAXED, __HIP_MEMORY_SCOPE_AGENT); }
__device__ __forceinline__ unsigned xb_xcc_id() { return (unsigned)__builtin_amdgcn_s_getreg((3 << 11) | 20) & 0xFu; }
#define XB_SPIN(cond, bar) do { unsigned _sp = 0; while (cond) { __builtin_amdgcn_s_sleep(1); \
    if ((++_sp & 255u) == 0u) { if (xb_ld(&(bar)[XB_TMO])) break; if (_sp > XB_SPIN_CAP) { atomicAdd(&(bar)[XB_TMO], 1u); break; } } } } while (0)
struct XcdBarrier { unsigned* bar; unsigned x; volatile LAS unsigned* st; };
__device__ __forceinline__ XcdBarrier xcd_barrier_post(unsigned* bar, volatile LAS unsigned* st) {
    XcdBarrier b; b.bar = bar; b.x = xb_xcc_id(); b.st = st;
    if (threadIdx.x == 0) (void)xb_add(&bar[XB_XCNT(b.x)], 1u);
    return b;
}
__device__ __forceinline__ void xcd_barrier_complete(unsigned* bar, unsigned x, unsigned& nloc, unsigned& nx) {
    const unsigned G = gridDim.x * gridDim.y * gridDim.z;
    unsigned sum, cnt, mine, sp = 0u;
    for (;;) {
        sum = 0u; cnt = 0u; mine = 0u;
#pragma unroll
        for (unsigned j = 0; j < 16; ++j) { const unsigned c = xb_ld(&bar[XB_XCNT(j)]); sum += c; cnt += (c > 0u) ? 1u : 0u; mine = (j == x) ? c : mine; }
        if (sum == G) break;
        __builtin_amdgcn_s_sleep(1);
        if ((++sp & 255u) == 0u) { if (xb_ld(&bar[XB_TMO])) break; if (sp > XB_SPIN_CAP) { atomicAdd(&bar[XB_TMO], 1u); break; } }
    }
    nloc = mine > 0u ? mine : 1u; nx = cnt > 0u ? cnt : 1u;
}
__device__ __forceinline__ void xcd_barrier(const XcdBarrier& b) {
    asm volatile("s_waitcnt vmcnt(0)" ::: "memory");
    __syncthreads();
    if (threadIdx.x == 0) {
        unsigned* bar = b.bar;
        __builtin_amdgcn_s_waitcnt(0);
        unsigned nloc = b.st[0], nx = b.st[1];
        if (nloc == 0u) { xcd_barrier_complete(bar, b.x, nloc, nx); b.st[0] = nloc; b.st[1] = nx; }
        const unsigned old = xb_add(&bar[XB_XSUB(b.x)], 1u);
        const unsigned gen = old / nloc;
        if (old + 1u == (gen + 1u) * nloc) {
            __builtin_amdgcn_fence(__ATOMIC_RELEASE, "agent");
            asm volatile("s_waitcnt vmcnt(0)" ::: "memory");
            const unsigned og = xb_add(&bar[XB_TOP], 1u);
            const unsigned tg = og / nx;
            asm volatile("buffer_inv sc1" ::: "memory");
            if (og + 1u == (tg + 1u) * nx) xb_add(&bar[XB_TOPGEN], 1u);
            else XB_SPIN(xb_ld(&bar[XB_TOPGEN]) == tg, bar);
            xb_add(&bar[XB_XGEN(b.x)], 1u);
            asm volatile("s_waitcnt vmcnt(0)" ::: "memory");
        } else {
            asm volatile("buffer_inv sc1" ::: "memory");
            XB_SPIN(xb_ld(&bar[XB_XGEN(b.x)]) == gen, bar);
            asm volatile("s_waitcnt vmcnt(0)" ::: "memory");
        }
    }
    __syncthreads();
}

__device__ __forceinline__ int lds_byte(int r, int c) { const int st = (r >> 4) * 2 + (c >> 5), rr = r & 15, cc = c & 31, ob = rr * 64 + cc * 2; return st * 1024 + (ob ^ (((ob >> 9) & 1) << 5)); }
__device__ __forceinline__ void stage_rc(int b, int& R, int& C) { const int st = b / 1024, sb = b % 1024, swz = sb ^ (((sb >> 9) & 1) << 5); R = (st >> 1) * 16 + swz / 64; C = (st & 1) * 32 + (swz % 64) / 2; }

__device__ __forceinline__ int perm32(int rho) { const int n = rho >> 4, i = rho & 15; return 8 * (i >> 2) + 4 * n + (i & 3); }
__device__ __forceinline__ void st_bf16x8(bf16_t* p, const f32x4 a, const f32x4 b) { uint4 o; o.x = cvt_pk_bf16(a[0], a[1]); o.y = cvt_pk_bf16(a[2], a[3]); o.z = cvt_pk_bf16(b[0], b[1]); o.w = cvt_pk_bf16(b[2], b[3]); *(uint4*)p = o; }
struct Unit { int pm, pn; };
struct Gemm { const bf16_t* A; const bf16_t* Bt; int M, N, K; };
struct StaticOrder {
    int nM, nN, nwg, G, c, wgm;
    __device__ void init(int M, int N, int G_, int c_, int wgm_ = WGM) { nM = M / BM; nN = N / BM; nwg = nM * nN; G = G_; c = c_; wgm = wgm_; }
    __device__ bool next(int i, Unit& u) const {
        const long L = (long)i * G + c; if (L >= nwg) return false;
        int wgid = (int)L; { const int q = nwg / NXCD, r = nwg % NXCD, xcd = wgid % NXCD, off = wgid / NXCD; wgid = (xcd < r ? xcd * (q + 1) : r * (q + 1) + (xcd - r) * q) + off; }
        const int nig = wgm * nN, gid = wgid / nig, fm = gid * wgm, gsz = (nM - fm) < wgm ? (nM - fm) : wgm;
        u.pm = fm + ((wgid % nig) % gsz); u.pn = (wgid % nig) / gsz; return true;
    }
};

#define EPI_MAIN_CALL \
    static constexpr bool AFTER_DRAIN = false; \
    __device__ __forceinline__ void operator()(const f32x4 (&acc)[2][2][4][2], const Unit& u, int wr, int wc, int fr, int fq) const { \
        const int rowb = u.pm * BM + wr * 64 + fr; \
        _Pragma("unroll") for (int ai = 0; ai < 2; ++ai) _Pragma("unroll") for (int m = 0; m < 4; ++m) { \
            const f32x4 a[2][2] = {{acc[ai][0][m][0], acc[ai][0][m][1]}, {acc[ai][1][m][0], acc[ai][1][m][1]}}; \
            row(a, rowb + ai * HALF + m * 16, u.pn, wc, fq); } }
struct EpiIn {
    bf16_t *pU, *pV, *pBG, *pZ; const float* g_v; float* out;
    __device__ __forceinline__ void row(const f32x4 (&a)[2][2], int row, int pn, int wc, int fq) const {
        if (pn < 2 || pn == 4 || pn == 5) {
            bf16_t* dst = (pn < 2 ? pU : pBG) + (size_t)row * 512 + (pn & 1) * 256 + wc * 32 + 8 * fq;
#pragma unroll
            for (int bj = 0; bj < 2; ++bj) { f32x4 v0 = a[bj][0], v1 = a[bj][1];
                if (pn < 2) {
#pragma unroll
                    for (int j = 0; j < 4; ++j) { v0[j] = gelu_tanh(v0[j]); v1[j] = gelu_tanh(v1[j]); } }
                st_bf16x8(dst + bj * HALF, v0, v1); }
        } else if (pn < 4) {
            const int head = (pn - 2) * 4 + wc;
            f32x4 g[2][2]; float ss = 0.f;
#pragma unroll
            for (int bj = 0; bj < 2; ++bj)
#pragma unroll
                for (int n = 0; n < 2; ++n)
#pragma unroll
                    for (int j = 0; j < 4; ++j) { const float t = gelu_tanh(a[bj][n][j]); g[bj][n][j] = t; ss += t * t; }
            ss += __shfl_xor(ss, 16); ss += __shfl_xor(ss, 32);
            const float rs = rsqrtf(ss * (1.f / 64.f) + EPS);
#pragma unroll
            for (int bj = 0; bj < 2; ++bj) { const int d = head * 64 + bj * 32 + 8 * fq;
                const f32x4 v0 = g[bj][0] * rs * *(const f32x4*)(g_v + d), v1 = g[bj][1] * rs * *(const f32x4*)(g_v + d + 4);
                st_bf16x8(pV + (size_t)row * 512 + d, v0, v1);
                if (row >= NP && row < NTOK) { float* o = out + O_VS + (size_t)(row - NP) * 512 + d; *(f32x4*)o = v0; *(f32x4*)(o + 4) = v1; } }
        } else {
            const int c = (pn - 6) * 128 + wc * 32 + 8 * fq;
            const f32x4 z0 = a[0][0] * a[1][0], z1 = a[0][1] * a[1][1];
            st_bf16x8(pZ + (size_t)row * 512 + c, z0, z1);
            float* o = nullptr;
            if (row < NP) { const int t = row & 2047; if (t >= 2046) o = out + O_CONVP + (size_t)((row >> 11) * 2 + (t - 2046)) * 512 + c; }
            else if (row < NTOK) o = out + O_CONVS + (size_t)((row - NP) * 2 + 1) * 512 + c;
            if (o) { *(f32x4*)o = z0; *(f32x4*)(o + 4) = z1; }
        }
    }
    EPI_MAIN_CALL
};
struct EpiRes {
    const float *xp, *xs, *mod; float* out; int gate_off; int inplace;
    __device__ __forceinline__ void row(const f32x4 (&a)[2][2], int row, int pn, int wc, int fq) const {
        if (row < NTOK) { const int cb = pn * BM + wc * 32 + 4 * fq;
            const float* gt = mod + (size_t)batch_of(row) * NMOD + gate_off; float* orow = out + (size_t)row * DM;
            const float* br = inplace ? orow : (row < NP ? xp + (size_t)row * DM : xs + (size_t)(row - NP) * DM);
#pragma unroll
            for (int bj = 0; bj < 2; ++bj)
#pragma unroll
                for (int n = 0; n < 2; ++n) { const int c = cb + bj * HALF + n * 16;
                    *(f32x4*)(orow + c) = *(const f32x4*)(br + c) + *(const f32x4*)(gt + c) * a[bj][n]; } }
    }
    __device__ __forceinline__ void frag(const f32x4 a, int row, int cs) const {
        const int c = (cs & ~31) + perm32(cs & 31);
        const float* gt = mod + (size_t)batch_of(row) * NMOD + gate_off; float* orow = out + (size_t)row * DM;
        const float* br = inplace ? orow : (row < NP ? xp + (size_t)row * DM : xs + (size_t)(row - NP) * DM);
        *(f32x4*)(orow + c) = *(const f32x4*)(br + c) + *(const f32x4*)(gt + c) * a; }
    EPI_MAIN_CALL
};
struct EpiRelu2 {
    bf16_t* T;
    __device__ __forceinline__ void row(const f32x4 (&a)[2][2], int row, int pn, int wc, int fq) const {
        bf16_t* rp = T + (size_t)row * DFF + pn * BM + wc * 32 + 8 * fq;
#pragma unroll
        for (int bj = 0; bj < 2; ++bj) { f32x4 v0 = a[bj][0], v1 = a[bj][1];
#pragma unroll
            for (int j = 0; j < 4; ++j) { const float r0 = fmaxf(v0[j], 0.f), r1 = fmaxf(v1[j], 0.f); v0[j] = r0 * r0; v1[j] = r1 * r1; }
            st_bf16x8(rp + bj * HALF, v0, v1); }
    }
    __device__ __forceinline__ void frag(f32x4 v, int row, int c) const {
#pragma unroll
        for (int j = 0; j < 4; ++j) { const float r = fmaxf(v[j], 0.f); v[j] = r * r; }
        st_bf16x4(T + (size_t)row * DFF + (c & ~31) + perm32(c & 31), v); }
    EPI_MAIN_CALL
};
struct EpiNull {
    float* sink; int flag;
    __device__ __forceinline__ void row(const f32x4 (&a)[2][2], int row, int pn, int wc, int fq) const {
        if (flag) { *(f32x4*)(sink + (size_t)row * DM + pn * BM + wc * 32 + 4 * fq) = a[0][0] + a[0][1] + a[1][0] + a[1][1]; } }
    EPI_MAIN_CALL
};
__device__ __forceinline__ void spin_until(unsigned* p, unsigned need) { unsigned sp = 0; while (xb_ld(p) < need) { __builtin_amdgcn_s_sleep(1); if (++sp > (1u << 20)) break; } }
template <int MODE>
struct EpiFused {
    static constexpr bool AFTER_DRAIN = true;
    const float *xp, *mod, *g; float* out; bf16_t* H; float* slots; unsigned* cnt; bf16_t* X1;
    __device__ __forceinline__ void fused(f32x4 (&acc)[2][2][4][2], const Unit& u, int wr, int wc, int fr, int fq, float* smem) const {
        const int tid = fresh_tid();
        const float* mb = mod + (size_t)(u.pm >> 3) * NMOD;
        const int cb = u.pn * BM + wc * 32 + 8 * fq, rl0 = wr * 64 + fr;
        float* part = smem; float* rsv = smem + 1024;
        f32x4 gt[2][2];
#pragma unroll
        for (int bj = 0; bj < 2; ++bj)
#pragma unroll
            for (int n = 0; n < 2; ++n) gt[bj][n] = *(const f32x4*)(mb + (MODE ? 5120 : 2048) + cb + bj * HALF + n * 4);
#pragma unroll
        for (int ai = 0; ai < 2; ++ai) {
            f32x4 bs[4][2][2];
#pragma unroll
            for (int m = 0; m < 4; ++m) { const size_t ro = (size_t)(u.pm * BM + rl0 + ai * HALF + m * 16) * DM;
#pragma unroll
                for (int bj = 0; bj < 2; ++bj)
#pragma unroll
                    for (int n = 0; n < 2; ++n) { const int c = cb + bj * HALF + n * 4;
                        if (MODE) { const uint2 q = *(const uint2*)(X1 + ro + c); bs[m][bj][n] = (f32x4){bf_lo(q.x), bf_hi(q.x), bf_lo(q.y), bf_hi(q.y)}; }
                        else bs[m][bj][n] = *(const f32x4*)(xp + ro + c); } }
            __builtin_amdgcn_sched_barrier(0);
#pragma unroll
            for (int m = 0; m < 4; ++m) { float ss = 0.f;
#pragma unroll
                for (int bj = 0; bj < 2; ++bj)
#pragma unroll
                    for (int n = 0; n < 2; ++n) { const f32x4 v = bs[m][bj][n] + gt[bj][n] * acc[ai][bj][m][n]; acc[ai][bj][m][n] = v; ss += v[0] * v[0] + v[1] * v[1] + v[2] * v[2] + v[3] * v[3]; }
                ss += __shfl_xor(ss, 16); ss += __shfl_xor(ss, 32);
                if (fq == 0) part[(rl0 + ai * HALF + m * 16) * 4 + wc] = ss; } }
        __syncthreads();
        if (tid < 256) { const f32x4 q = *(const f32x4*)(part + tid * 4); __hip_atomic_store(slots + (size_t)(u.pm * 4 + u.pn) * 256 + tid, (q[0] + q[1]) + (q[2] + q[3]), __ATOMIC_RELAXED, __HIP_MEMORY_SCOPE_AGENT); }
        asm volatile("s_waitcnt vmcnt(0)" ::: "memory");
        __syncthreads();
        if (tid == 0) { xb_add(cnt + u.pm * 64, 1u); spin_until(cnt + u.pm * 64, 4u); }
        f32x4 gs[2][2], sh[2][2];
#pragma unroll
        for (int bj = 0; bj < 2; ++bj)
#pragma unroll
            for (int n = 0; n < 2; ++n) { const int c = cb + bj * HALF + n * 4; gs[bj][n] = *(const f32x4*)(g + c);
                if (MODE == 0) { gs[bj][n] = gs[bj][n] * (*(const f32x4*)(mb + 4096 + c) + 1.f); sh[bj][n] = *(const f32x4*)(mb + 3072 + c); } }
        __syncthreads();
        if (tid < 256) { float s = 0.f;
#pragma unroll
            for (int q = 0; q < 4; ++q) s += __hip_atomic_load(slots + (size_t)(u.pm * 4 + q) * 256 + tid, __ATOMIC_RELAXED, __HIP_MEMORY_SCOPE_AGENT);
            rsv[tid] = rsqrtf(s * (1.f / DM) + EPS); }
        __syncthreads();
#pragma unroll
        for (int ai = 0; ai < 2; ++ai)
#pragma unroll
            for (int m = 0; m < 4; ++m) { const int rl = rl0 + ai * HALF + m * 16; const size_t ro = (size_t)(u.pm * BM + rl) * DM; const float r = rsv[rl];
#pragma unroll
                for (int bj = 0; bj < 2; ++bj) { const int c = cb + bj * HALF; const f32x4 v0 = acc[ai][bj][m][0], v1 = acc[ai][bj][m][1];
                    if (MODE == 0) { st_bf16x8(X1 + ro + c, v0, v1); st_bf16x8(H + ro + c, v0 * r * gs[bj][0] + sh[bj][0], v1 * r * gs[bj][1] + sh[bj][1]); }
                    else { *(f32x4*)(out + ro + c) = v0 * r * gs[bj][0]; *(f32x4*)(out + ro + c + 4) = v1 * r * gs[bj][1]; } } }
        __syncthreads();
    }
};
struct EpiMod {
    float* mod; const float* b_ada;
    __device__ __forceinline__ void frag(const f32x4 a, int row, int c) const { if (row < NB) *(f32x4*)(mod + (size_t)row * NMOD + c) = a + *(const f32x4*)(b_ada + c); }
    __device__ __forceinline__ void row(const f32x4 (&a)[2][2], int row, int pn, int wc, int fq) const {
        if (row < NB) { const int cb = pn * BM + wc * 32 + 4 * fq;
#pragma unroll
            for (int bj = 0; bj < 2; ++bj)
#pragma unroll
                for (int n = 0; n < 2; ++n) { const int c = cb + bj * HALF + n * 16; *(f32x4*)(mod + (size_t)row * NMOD + c) = a[bj][n] + *(const f32x4*)(b_ada + c); } }
    }
};

template <class Epi>
__device__ __forceinline__ void small_gemm(const bf16_t* __restrict__ A, int nm16, const bf16_t* __restrict__ Bt, int N, int K, const Epi& E, int row_base, float* smem, int blk, int nblk) {
    if (blk < 0) return;
    const int tid = fresh_tid(), w = tid >> 6, lane = tid & 63, fr = lane & 15, fq = lane >> 4;
    const int ntasks = (N / 256) * 4 * nm16, kw = K / 8;
    f32x4* red = (f32x4*)smem;
    for (int t = blk; t < ntasks; t += nblk) {
        const int m16 = t % nm16, r = t / nm16, wc = r & 3, pn = r >> 2;
        const bf16_t* ap = A + (size_t)(m16 * 16 + fr) * K + w * kw + fq * 8;
        const bf16_t* bp = Bt + (size_t)(pn * 256 + wc * 32 + fr) * K + w * kw + fq * 8;
        f32x4 acc[2][2] = {{{0.f, 0.f, 0.f, 0.f}, {0.f, 0.f, 0.f, 0.f}}, {{0.f, 0.f, 0.f, 0.f}, {0.f, 0.f, 0.f, 0.f}}};
#pragma unroll 4
        for (int ks = 0; ks < kw / 32; ++ks) {
            Frag a; a.q = *(const uint4*)(ap + ks * 32);
#pragma unroll
            for (int bj = 0; bj < 2; ++bj)
#pragma unroll
                for (int n = 0; n < 2; ++n) { Frag b; b.q = *(const uint4*)(bp + (size_t)(bj * 128 + n * 16) * K + ks * 32);
                    acc[bj][n] = __builtin_amdgcn_mfma_f32_16x16x32_bf16(b.v, a.v, acc[bj][n], 0, 0, 0); }
        }
#pragma unroll
        for (int i = 0; i < 4; ++i) red[(w * 4 + i) * 64 + lane] = acc[i >> 1][i & 1];
        __syncthreads();
        if (w == 0) { f32x4 s[2][2];
#pragma unroll
            for (int i = 0; i < 4; ++i) { f32x4 v = red[i * 64 + lane];
#pragma unroll
                for (int w2 = 1; w2 < 8; ++w2) v += red[(w2 * 4 + i) * 64 + lane];
                s[i >> 1][i & 1] = v; }
            E.row(s, row_base + m16 * 16 + fr, pn, wc, fq); }
        __syncthreads();
    }
}


template <int KSPLIT, int BATCH, bool SHAREB = false, class Epi>
__device__ __forceinline__ void small_gemm_w(const bf16_t* __restrict__ A, int nm16, const bf16_t* __restrict__ Bt, int N, int K, const Epi& E, int row_base, float* smem) {
    const int tid = fresh_tid(), w = tid >> 6, lane = tid & 63, fr = lane & 15, fq = lane >> 4;
    const int total = nm16 * (N / 16) * KSPLIT, kw = K / KSPLIT;
    f32x4* red = (f32x4*)smem;
    for (int base = blockIdx.x * 8; base < total; base += gridDim.x * 8) {
        const int task = base + w; const bool valid = task < total;
        const int tile = task / KSPLIT, ks = task % KSPLIT, m16 = tile % nm16, n16 = tile / nm16;
        f32x4 acc = {0.f, 0.f, 0.f, 0.f};
        if (KSPLIT == 1 && SHAREB) {
            __syncthreads();
            uint4* Bs = (uint4*)smem; const int nst = kw / 32, per = nst / 8;
            const bf16_t* bpb = Bt + (size_t)((base / nm16) * 16 + fr) * K + fq * 8;
            for (int j = 0; j < per; ++j) { const int s = w * per + j; Bs[s * 64 + lane] = *(const uint4*)(bpb + s * 32); }
            __syncthreads();
            if (valid) {
                const bf16_t* ap = A + (size_t)(m16 * 16 + fr) * K + fq * 8;
                for (int s0 = 0; s0 < nst; s0 += BATCH) { Frag a[BATCH];
#pragma unroll
                    for (int i = 0; i < BATCH; ++i) a[i].q = *(const uint4*)(ap + (s0 + i) * 32);
                    __builtin_amdgcn_sched_barrier(0);
#pragma unroll
                    for (int i = 0; i < BATCH; ++i) { Frag b; b.q = Bs[(s0 + i) * 64 + lane]; acc = __builtin_amdgcn_mfma_f32_16x16x32_bf16(b.v, a[i].v, acc, 0, 0, 0); }
                    __builtin_amdgcn_sched_barrier(0); } }
            __syncthreads();
        } else if (valid) {
            const bf16_t* ap = A + (size_t)(m16 * 16 + fr) * K + ks * kw + fq * 8;
            const bf16_t* bp = Bt + (size_t)(n16 * 16 + fr) * K + ks * kw + fq * 8;
            for (int s0 = 0; s0 < kw / 32; s0 += BATCH) { Frag a[BATCH], b[BATCH];
#pragma unroll
                for (int i = 0; i < BATCH; ++i) { a[i].q = *(const uint4*)(ap + (s0 + i) * 32); b[i].q = *(const uint4*)(bp + (s0 + i) * 32); }
                __builtin_amdgcn_sched_barrier(0);
#pragma unroll
                for (int i = 0; i < BATCH; ++i) acc = __builtin_amdgcn_mfma_f32_16x16x32_bf16(b[i].v, a[i].v, acc, 0, 0, 0);
                __builtin_amdgcn_sched_barrier(0); }
        }
        if (KSPLIT > 1) {
            red[w * 64 + lane] = acc;
            __syncthreads();
            if (ks == 0) {
#pragma unroll
                for (int j = 1; j < KSPLIT; ++j) acc += red[(w + j) * 64 + lane]; }
        }
        if (valid && ks == 0) E.frag(acc, row_base + m16 * 16 + fr, n16 * 16 + 4 * fq);
        if (KSPLIT > 1) __syncthreads();
    }
}

template <class Epi>
__device__ __forceinline__ void gemm_phase(LAS unsigned char* lds, const Gemm g, const StaticOrder& S, const Epi& E, float* smem = nullptr) {
    const int tid = fresh_tid(), wid = __builtin_amdgcn_readfirstlane(tid >> 6), lane = tid & 63, wr = wid >> 2, wc = wid & 3, fr = lane & 15, fq = lane >> 4;
    const int K = g.K, nt = K / BK;
    unsigned voffA[2];
#pragma unroll
    for (int i = 0; i < 2; ++i) { int R, C; stage_rc(tid * 16 + i * 8192, R, C); voffA[i] = (unsigned)(R * K + C) * 2u; }
    const size_t kstep = (size_t)(BK * 2), hstep = (size_t)HALF * K * 2, tstep = 2 * hstep;
    const unsigned ldsw = (unsigned)wid * 1024u;
    const int aoff = lds_byte(wr * 64 + fr, fq * 8), boff = lds_byte(wc * 32 + fr, fq * 8);
#define PG8_SA(b, h) (((b) * 2 + (h)) * HTB)
#define PG8_SB(b, h) ((4 + (b) * 2 + (h)) * HTB)
#define PG8_STAGE(bufoff, gbase, voff) do { _Pragma("unroll") for (int _i = 0; _i < 2; ++_i) \
        __builtin_amdgcn_global_load_lds((const unsigned*)((const char*)(gbase) + (voff)[_i]), (LAS unsigned*)(lds + (bufoff) + ldsw + _i * 8192), 16, 0, 0); } while (0)
#define PG8_LDA(dst, b, h) do { _Pragma("unroll") for (int m = 0; m < 4; ++m) _Pragma("unroll") for (int k = 0; k < 2; ++k) dst[m][k] = *(const LAS bf16x8*)(lds + PG8_SA(b, h) + aoff + m * 2048 + k * 1024); } while (0)
#define PG8_LDB(dst, b, h) do { _Pragma("unroll") for (int n = 0; n < 2; ++n) _Pragma("unroll") for (int k = 0; k < 2; ++k) dst[n][k] = *(const LAS bf16x8*)(lds + PG8_SB(b, h) + boff + n * 2048 + k * 1024); } while (0)
#define PG8_MMA(ai, bj, At, Bt) do { __builtin_amdgcn_s_setprio(1); _Pragma("unroll") for (int m = 0; m < 4; ++m) _Pragma("unroll") for (int n = 0; n < 2; ++n) _Pragma("unroll") for (int k = 0; k < 2; ++k) \
        acc[ai][bj][m][n] = __builtin_amdgcn_mfma_f32_16x16x32_bf16(Bt[n][k], At[m][k], acc[ai][bj][m][n], 0, 0, 0); __builtin_amdgcn_s_setprio(0); } while (0)
#define PG8_WAIT_V(n) asm volatile("s_waitcnt vmcnt(" #n ")" ::: "memory")
#define PG8_WAIT_L(n) asm volatile("s_waitcnt lgkmcnt(" #n ")" ::: "memory")
#define PG8_BAR __builtin_amdgcn_s_barrier()
#define PG8_SCHED __builtin_amdgcn_sched_barrier(0)
    Unit cur, nxt; int ui = 0;
    if (!S.next(0, cur)) return;
    f32x4 acc[2][2][4][2];
#pragma unroll
    for (int a = 0; a < 2; ++a)
#pragma unroll
        for (int b = 0; b < 2; ++b)
#pragma unroll
            for (int m = 0; m < 4; ++m)
#pragma unroll
                for (int n = 0; n < 2; ++n) acc[a][b][m][n] = (f32x4){0.f, 0.f, 0.f, 0.f};
    bf16x8 At[4][2], B0[2][2], B1[2][2];
    const char* cA = (const char*)g.A + (size_t)cur.pm * tstep; const char* cB = (const char*)g.Bt + (size_t)cur.pn * tstep;
    PG8_STAGE(PG8_SB(0, 0), cB, voffA); PG8_STAGE(PG8_SA(0, 0), cA, voffA); PG8_STAGE(PG8_SB(0, 1), cB + hstep, voffA); PG8_STAGE(PG8_SA(0, 1), cA + hstep, voffA);
    if (wr == 1) PG8_BAR;
    PG8_WAIT_V(4); PG8_BAR;
    PG8_STAGE(PG8_SB(1, 0), cB + kstep, voffA); PG8_STAGE(PG8_SA(1, 0), cA + kstep, voffA); PG8_STAGE(PG8_SB(1, 1), cB + hstep + kstep, voffA);
    PG8_WAIT_V(6); PG8_BAR;
    for (;;) {
        const bool has_next = S.next(ui + 1, nxt);
        const char* nA = has_next ? (const char*)g.A + (size_t)nxt.pm * tstep : cA; const char* nB = has_next ? (const char*)g.Bt + (size_t)nxt.pn * tstep : cB;
        for (int t = 0; t < nt; t += 2) {
            const bool last = (t == nt - 2);
            const char* a1 = cA + (size_t)(t + 1) * kstep;
            const char* a2 = last ? nA : cA + (size_t)(t + 2) * kstep; const char* b2 = last ? nB : cB + (size_t)(t + 2) * kstep;
            const char* a3 = a2 + kstep; const char* b3 = b2 + kstep;
            PG8_LDB(B0, 0, 0); PG8_SCHED; PG8_LDA(At, 0, 0); PG8_STAGE(PG8_SA(1, 1), a1 + hstep, voffA);
            PG8_WAIT_L(8); PG8_BAR; PG8_WAIT_L(0); PG8_MMA(0, 0, At, B0); PG8_BAR; PG8_SCHED;
            PG8_LDB(B1, 0, 1); PG8_STAGE(PG8_SB(0, 0), b2, voffA);
            PG8_BAR; PG8_WAIT_L(0); PG8_MMA(0, 1, At, B1); PG8_BAR;
            PG8_LDA(At, 0, 1); PG8_STAGE(PG8_SA(0, 0), a2, voffA);
            PG8_BAR; PG8_WAIT_L(0); PG8_MMA(1, 0, At, B0); PG8_BAR; PG8_SCHED;
            PG8_STAGE(PG8_SB(0, 1), b2 + hstep, voffA);
            PG8_WAIT_V(6); PG8_BAR; PG8_MMA(1, 1, At, B1); PG8_BAR;
            PG8_LDB(B0, 1, 0); PG8_SCHED; PG8_LDA(At, 1, 0); PG8_STAGE(PG8_SA(0, 1), a2 + hstep, voffA);
            PG8_WAIT_L(8); PG8_BAR; PG8_WAIT_L(0); PG8_MMA(0, 0, At, B0); PG8_BAR; PG8_SCHED;
            PG8_LDB(B1, 1, 1); PG8_STAGE(PG8_SB(1, 0), b3, voffA);
            PG8_BAR; PG8_WAIT_L(0); PG8_MMA(0, 1, At, B1); PG8_BAR;
            PG8_LDA(At, 1, 1); PG8_STAGE(PG8_SA(1, 0), a3, voffA);
            PG8_BAR; PG8_WAIT_L(0); PG8_MMA(1, 0, At, B0); PG8_BAR; PG8_SCHED;
            PG8_STAGE(PG8_SB(1, 1), b3 + hstep, voffA);
            PG8_WAIT_V(6); PG8_BAR; PG8_MMA(1, 1, At, B1); PG8_BAR;
        }
        if constexpr (!Epi::AFTER_DRAIN) E(acc, cur, wr, wc, fr, fq);
        if (!has_next) break;
#pragma unroll
        for (int a = 0; a < 2; ++a)
#pragma unroll
            for (int b = 0; b < 2; ++b)
#pragma unroll
                for (int m = 0; m < 4; ++m)
#pragma unroll
                    for (int n = 0; n < 2; ++n) acc[a][b][m][n] = (f32x4){0.f, 0.f, 0.f, 0.f};
        cur = nxt; cA = nA; cB = nB; ++ui;
    }
    PG8_WAIT_V(0);
    if (wr == 0) PG8_BAR;
    PG8_BAR;
    if constexpr (Epi::AFTER_DRAIN) E.fused(acc, cur, wr, wc, fr, fq, smem);
#undef PG8_SA
#undef PG8_SB
#undef PG8_STAGE
#undef PG8_LDA
#undef PG8_LDB
#undef PG8_MMA
#undef PG8_WAIT_V
#undef PG8_WAIT_L
#undef PG8_BAR
#undef PG8_SCHED
}

__device__ __forceinline__ int win_src_col(int np) {
    const int tile = np >> 8, s = np & 255;
    if (tile < 2 || tile == 4 || tile == 5) return np;
    if (tile < 4) { const int bj = s >> 7, wc = (s >> 5) & 3, i = s & 31; return 512 + (tile - 2) * 256 + wc * 64 + bj * 32 + i; }
    return 1536 + (s >> 7) * 512 + (tile - 6) * 128 + (s & 127);
}
template <bool PERMW, bool PERM32>
__device__ __forceinline__ void transpose_cvt(const float* __restrict__ src, bf16_t* __restrict__ dst, int K, int N, float* T, int& tile_ctr, int blk, int nblk) {
    const int tid = fresh_tid(), nkt = K / 64, ntiles = nkt * (N / 256);
    int tl0 = (blk - tile_ctr) % nblk; if (tl0 < 0) tl0 += nblk;
    tile_ctr += ntiles;
    for (int tl = tl0; tl < ntiles; tl += nblk) {
        const int k0 = (tl % nkt) * 64, n0 = (tl / nkt) * 256;
        { const int n4 = (tid & 63) * 4, sc = PERMW ? win_src_col(n0 + n4) : n0 + n4; f32x4 v[8];
#pragma unroll
          for (int i = 0; i < 8; ++i) { const int k = (tid >> 6) + 8 * i; v[i] = *(const f32x4*)(src + (size_t)(k0 + k) * N + sc); }
#pragma unroll
          for (int i = 0; i < 8; ++i) { const int k = (tid >> 6) + 8 * i; *(f32x4*)(T + k * 256 + (n4 ^ (((k >> 3) & 7) << 2))) = v[i]; } }
        __syncthreads();
#pragma unroll
        for (int i = 0; i < 4; ++i) { const int pi = tid + 512 * i, q = pi & 7, nl = pi >> 3, x = PERM32 ? (nl & ~31) + perm32(nl & 31) : nl; const float* tp = T + (8 * q) * 256 + (x ^ (q << 2)); uint4 o;
            o.x = cvt_pk_bf16(tp[0], tp[256]); o.y = cvt_pk_bf16(tp[512], tp[768]); o.z = cvt_pk_bf16(tp[1024], tp[1280]); o.w = cvt_pk_bf16(tp[1536], tp[1792]);
            *(uint4*)(dst + (size_t)(n0 + nl) * K + k0 + 8 * q) = o; }
        __syncthreads();
    }
}
__device__ __forceinline__ void mod_phase(const Params& p, const bf16_t* __restrict__ Sb, float* smem) {
    const int tid = fresh_tid(), w = tid >> 6, lane = tid & 63, fr = lane & 15, fq = lane >> 4;
    f32x4* red = (f32x4*)smem; float* mod = (float*)(p.ws + WS_MOD);
    for (int it = blockIdx.x; it < NMOD / 32; it += gridDim.x) {
        const int col0 = it * 32;
        f32x4 acc[2][9];
#pragma unroll
        for (int i = 0; i < 9; ++i) { acc[0][i] = (f32x4){0.f, 0.f, 0.f, 0.f}; acc[1][i] = (f32x4){0.f, 0.f, 0.f, 0.f}; }
        Frag wfA[4], wfB[4];
#pragma unroll
        for (int kk = 0; kk < 4; ++kk) { const float* wp = p.w_ada + (size_t)(w * 128 + kk * 32 + fq * 8) * NMOD + col0 + 2 * fr;
#pragma unroll
            for (int i = 0; i < 4; ++i) { const float2 v0 = *(const float2*)(wp + (size_t)(2 * i) * NMOD), v1 = *(const float2*)(wp + (size_t)(2 * i + 1) * NMOD);
                wfA[kk].u[i] = cvt_pk_bf16(v0.x, v1.x); wfB[kk].u[i] = cvt_pk_bf16(v0.y, v1.y); } }
#pragma unroll
        for (int kk = 0; kk < 4; ++kk) {
#pragma unroll
            for (int bt = 0; bt < 9; ++bt) { Frag sf; sf.q = *(const uint4*)(Sb + (size_t)(bt * 16 + fr) * DM + w * 128 + kk * 32 + fq * 8);
                acc[0][bt] = __builtin_amdgcn_mfma_f32_16x16x32_bf16(wfA[kk].v, sf.v, acc[0][bt], 0, 0, 0);
                acc[1][bt] = __builtin_amdgcn_mfma_f32_16x16x32_bf16(wfB[kk].v, sf.v, acc[1][bt], 0, 0, 0); } }
        if (w >= 4) {
#pragma unroll
            for (int bt = 0; bt < 9; ++bt) { red[((w - 4) * 18 + bt) * 64 + lane] = acc[0][bt]; red[((w - 4) * 18 + 9 + bt) * 64 + lane] = acc[1][bt]; } }
        __syncthreads();
        if (w < 4) {
#pragma unroll
            for (int bt = 0; bt < 9; ++bt) { acc[0][bt] += red[(w * 18 + bt) * 64 + lane]; acc[1][bt] += red[(w * 18 + 9 + bt) * 64 + lane]; } }
        __syncthreads();
        if (w < 4) {
#pragma unroll
            for (int bt = 0; bt < 9; ++bt) { red[(w * 18 + bt) * 64 + lane] = acc[0][bt]; red[(w * 18 + 9 + bt) * 64 + lane] = acc[1][bt]; } }
        __syncthreads();
        for (int idx = tid; idx < 9 * 64; idx += 512) { const int bt = idx >> 6, l = idx & 63; f32x4 sa = red[bt * 64 + l], sb = red[(9 + bt) * 64 + l];
#pragma unroll
            for (int w2 = 1; w2 < 4; ++w2) { sa += red[(w2 * 18 + bt) * 64 + l]; sb += red[(w2 * 18 + 9 + bt) * 64 + l]; }
            const int b = bt * 16 + (l & 15), j = col0 + (l >> 4) * 8;
            if (b < NB) { float* mp = mod + (size_t)b * NMOD + j;
                *(f32x4*)mp = (f32x4){sa[0], sb[0], sa[1], sb[1]} + *(const f32x4*)(p.b_ada + j);
                *(f32x4*)(mp + 4) = (f32x4){sa[2], sb[2], sa[3], sb[3]} + *(const f32x4*)(p.b_ada + j + 4); } }
        __syncthreads();
    }
}
template <bool FINAL>
__device__ __forceinline__ void rownorm_phase(const Params& p, const float* g, int sh_off, int sc_off, bool from_out, int r0 = 0, int r1 = NTOK, int nblk = 0) {
    const int tid = fresh_tid(), lane = tid & 63, gw = blockIdx.x * 8 + (tid >> 6), nw = (nblk ? nblk : (int)gridDim.x) * 8;
    const float* mod = (const float*)(p.ws + WS_MOD); bf16_t* H = (bf16_t*)(p.ws + WS_H);
    f32x4 gv[4];
#pragma unroll
    for (int i = 0; i < 4; ++i) gv[i] = *(const f32x4*)(g + (i >> 1) * 512 + lane * 8 + (i & 1) * 4);
    for (int rowb = r0 + gw; rowb < r1; rowb += 4 * nw) {
        f32x4 v[4][4];
#pragma unroll
        for (int q = 0; q < 4; ++q) { const int row = rowb + q * nw;
            if (row < r1) { const float* src = from_out ? p.out + (size_t)row * DM : (row < NP ? p.x_prompt + (size_t)row * DM : p.x_sample + (size_t)(row - NP) * DM);
#pragma unroll
                for (int i = 0; i < 4; ++i) v[q][i] = *(const f32x4*)(src + (i >> 1) * 512 + lane * 8 + (i & 1) * 4); }
            else {
#pragma unroll
                for (int i = 0; i < 4; ++i) v[q][i] = (f32x4){0.f, 0.f, 0.f, 0.f}; } }
        __builtin_amdgcn_sched_barrier(0);
        float rs[4];
#pragma unroll
        for (int q = 0; q < 4; ++q) { float ss = 0.f;
#pragma unroll
            for (int i = 0; i < 4; ++i) ss += v[q][i][0] * v[q][i][0] + v[q][i][1] * v[q][i][1] + v[q][i][2] * v[q][i][2] + v[q][i][3] * v[q][i][3];
#pragma unroll
            for (int o = 1; o < 64; o <<= 1) ss += __shfl_xor(ss, o);
            rs[q] = rsqrtf(ss * (1.f / DM) + EPS); }
#pragma unroll
        for (int q = 0; q < 4; ++q) { const int row = rowb + q * nw;
            if (row < r1) { const float* mb = mod + (size_t)batch_of(row) * NMOD;
#pragma unroll
                for (int h = 0; h < 2; ++h) { const int c = h * 512 + lane * 8;
                    const f32x4 y0 = v[q][2 * h] * rs[q] * gv[2 * h], y1 = v[q][2 * h + 1] * rs[q] * gv[2 * h + 1];
                    if (FINAL) { *(f32x4*)(p.out + (size_t)row * DM + c) = y0; *(f32x4*)(p.out + (size_t)row * DM + c + 4) = y1; }
                    else st_bf16x8(H + (size_t)row * DM + c, y0 * (*(const f32x4*)(mb + sc_off + c) + 1.f) + *(const f32x4*)(mb + sh_off + c),
                                                             y1 * (*(const f32x4*)(mb + sc_off + c + 4) + 1.f) + *(const f32x4*)(mb + sh_off + c + 4)); } } }
    }
}
__device__ __forceinline__ void p1_prompt_rows(const Params& p) {
    const int tid = fresh_tid(), lane = tid & 63, gw = blockIdx.x * 8 + (tid >> 6);
    const float* mb = (const float*)(p.ws + WS_MOD) + (size_t)(gw >> 8) * NMOD; bf16_t* H = (bf16_t*)(p.ws + WS_H);
    f32x4 gs[4], sh[4];
#pragma unroll
    for (int i = 0; i < 4; ++i) { const int c = (i >> 1) * 512 + lane * 8 + (i & 1) * 4; gs[i] = *(const f32x4*)(p.g_mix + c) * (*(const f32x4*)(mb + 1024 + c) + 1.f); sh[i] = *(const f32x4*)(mb + c); }
#pragma unroll
    for (int trip = 0; trip < 2; ++trip) { const int rowb = gw * 8 + trip * 4;
        f32x4 v[4][4];
#pragma unroll
        for (int q = 0; q < 4; ++q)
#pragma unroll
            for (int i = 0; i < 4; ++i) v[q][i] = *(const f32x4*)(p.x_prompt + (size_t)(rowb + q) * DM + (i >> 1) * 512 + lane * 8 + (i & 1) * 4);
        __builtin_amdgcn_sched_barrier(0);
#pragma unroll
        for (int q = 0; q < 4; ++q) { float ss = 0.f;
#pragma unroll
            for (int i = 0; i < 4; ++i) ss += v[q][i][0] * v[q][i][0] + v[q][i][1] * v[q][i][1] + v[q][i][2] * v[q][i][2] + v[q][i][3] * v[q][i][3];
#pragma unroll
            for (int o = 1; o < 64; o <<= 1) ss += __shfl_xor(ss, o);
            const float rs = rsqrtf(ss * (1.f / DM) + EPS);
#pragma unroll
            for (int h = 0; h < 2; ++h) st_bf16x8(H + (size_t)(rowb + q) * DM + h * 512 + lane * 8, v[q][2 * h] * rs * gs[2 * h] + sh[2 * h], v[q][2 * h + 1] * rs * gs[2 * h + 1] + sh[2 * h + 1]); }
    }
}
__device__ __forceinline__ void mixer_phase(const Params& p, unsigned char* smem) {
    const int tid = fresh_tid(), w = tid >> 6, lane = tid & 63, fr = lane & 15, fq = lane >> 4;
    const bf16_t* pU = (const bf16_t*)(p.ws + WS_PU); const bf16_t* pV = (const bf16_t*)(p.ws + WS_PV); const bf16_t* pBG = (const bf16_t*)(p.ws + WS_PBG); const bf16_t* pZ = (const bf16_t*)(p.ws + WS_PZ);
    bf16_t* mA = (bf16_t*)(p.ws + WS_MA); const bf16_t* Wt = (const bf16_t*)(p.ws + WS_WTRIL);
    bf16_t* Vs = (bf16_t*)smem;
    for (int item = blockIdx.x; item < 256; item += gridDim.x) {
        const int hh = item & 1, bc = item >> 1, row0 = (bc >> 4) * 2048 + (bc & 15) * 128;
#pragma unroll
        for (int i = 0; i < 8; ++i) { const int pi = tid + 512 * i, s = pi >> 5, c16 = pi & 31, hl = c16 >> 3, d = (c16 & 7) * 8;
            *(uint4*)(Vs + ((hl * 128 + s) * 72 + d)) = *(const uint4*)(pV + (size_t)(row0 + s) * 512 + hh * 256 + c16 * 8); }
        __syncthreads();
        const int hl = w >> 1, thalf = w & 1, head = hh * 4 + hl;
        f32x4 acc[4][4];
#pragma unroll
        for (int a = 0; a < 4; ++a)
#pragma unroll
            for (int b = 0; b < 4; ++b) acc[a][b] = (f32x4){0.f, 0.f, 0.f, 0.f};
#pragma unroll
        for (int ks = 0; ks < 4; ++ks) {
            if (ks < 2 + 2 * thalf) {
                Frag af[4];
#pragma unroll
                for (int mt = 0; mt < 4; ++mt) af[mt].q = *(const uint4*)(Wt + ((size_t)(head * 128 + thalf * 64 + mt * 16 + fr) * 128 + ks * 32 + fq * 8));
#pragma unroll
                for (int nt = 0; nt < 4; ++nt) { Frag bf; const bf16_t* vp = Vs + ((hl * 128 + ks * 32 + fq * 8) * 72 + (nt >> 1) * 32 + perm32((nt & 1) * 16 + fr));
#pragma unroll
                    for (int i = 0; i < 4; ++i) bf.u[i] = (unsigned)vp[(2 * i) * 72] | ((unsigned)vp[(2 * i + 1) * 72] << 16);
#pragma unroll
                    for (int mt = 0; mt < 4; ++mt) acc[mt][nt] = __builtin_amdgcn_mfma_f32_16x16x32_bf16(bf.v, af[mt].v, acc[mt][nt], 0, 0, 0); }
            }
        }
#pragma unroll
        for (int mt = 0; mt < 4; ++mt) { const int t = thalf * 64 + mt * 16 + fr, row = row0 + t; const float bias = p.b_s[head * 128 + t];
#pragma unroll
            for (int pp = 0; pp < 2; ++pp) { const int col = head * 64 + pp * 32 + fq * 8; float u[8]; unpack8(*(const uint4*)(pU + (size_t)row * 512 + col), u);
                f32x4 o0 = acc[mt][2 * pp] + bias, o1 = acc[mt][2 * pp + 1] + bias;
#pragma unroll
                for (int j = 0; j < 4; ++j) { o0[j] *= u[j]; o1[j] *= u[4 + j]; }
                st_bf16x8(mA + (size_t)row * DM + col, o0, o1); } }
        __syncthreads();
    }
    for (int idx = blockIdx.x * 512 + tid; idx < (NP / 8) * 64; idx += gridDim.x * 512) {
        const int row0 = (idx >> 6) * 8, c = (idx & 63) * 8, t0 = row0 & 2047;
        uint4 zq[10], bq[8];
#pragma unroll
        for (int i = 0; i < 10; ++i) { zq[i] = make_uint4(0u, 0u, 0u, 0u); if (i >= 2 || t0 > 0) zq[i] = *(const uint4*)(pZ + (size_t)(row0 + i - 2) * 512 + c); }
#pragma unroll
        for (int i = 0; i < 8; ++i) bq[i] = *(const uint4*)(pBG + (size_t)(row0 + i) * 512 + c);
        float w0[8], w1[8], w2[8];
#pragma unroll
        for (int j = 0; j < 8; ++j) { w0[j] = p.w_conv[c + j]; w1[j] = p.w_conv[512 + c + j]; w2[j] = p.w_conv[1024 + c + j]; }
#pragma unroll
        for (int i = 0; i < 8; ++i) { float za[8], zb[8], zc[8], bg[8], y[8];
            unpack8(zq[i], za); unpack8(zq[i + 1], zb); unpack8(zq[i + 2], zc); unpack8(bq[i], bg);
#pragma unroll
            for (int j = 0; j < 8; ++j) y[j] = bg[j] * (w0[j] * za[j] + w1[j] * zb[j] + w2[j] * zc[j]);
            uint4 o; o.x = cvt_pk_bf16(y[0], y[1]); o.y = cvt_pk_bf16(y[2], y[3]); o.z = cvt_pk_bf16(y[4], y[5]); o.w = cvt_pk_bf16(y[6], y[7]);
            *(uint4*)(mA + (size_t)(row0 + i) * DM + 512 + c) = o; }
    }
    for (int idx = blockIdx.x * 512 + tid; idx < 128 * 64; idx += gridDim.x * 512) {
        const int i = idx >> 6, row = NP + i, c = (idx & 63) * 8;
        float z[8], bg[8], z1[8], z2[8], y[8], u[8], v[8];
        unpack8(*(const uint4*)(pZ + (size_t)row * 512 + c), z); unpack8(*(const uint4*)(pBG + (size_t)row * 512 + c), bg);
        unpack8(*(const uint4*)(pU + (size_t)row * 512 + c), u); unpack8(*(const uint4*)(pV + (size_t)row * 512 + c), v);
        const float* sp = p.state_conv + (size_t)i * 1024 + c;
#pragma unroll
        for (int j = 0; j < 8; ++j) { z2[j] = sp[j]; z1[j] = sp[512 + j]; }
        float* oc = p.out + O_CONVS + (size_t)i * 1024 + c;
        *(f32x4*)oc = (f32x4){z1[0], z1[1], z1[2], z1[3]}; *(f32x4*)(oc + 4) = (f32x4){z1[4], z1[5], z1[6], z1[7]};
        const int h = c >> 6; const float w00 = p.w_s[(size_t)h * 128 * 128], b0 = p.b_s[h * 128];
        uint4 o; o.x = cvt_pk_bf16(u[0] * (w00 * v[0] + b0), u[1] * (w00 * v[1] + b0)); o.y = cvt_pk_bf16(u[2] * (w00 * v[2] + b0), u[3] * (w00 * v[3] + b0));
        o.z = cvt_pk_bf16(u[4] * (w00 * v[4] + b0), u[5] * (w00 * v[5] + b0)); o.w = cvt_pk_bf16(u[6] * (w00 * v[6] + b0), u[7] * (w00 * v[7] + b0));
        *(uint4*)(mA + (size_t)row * DM + c) = o;
#pragma unroll
        for (int j = 0; j < 8; ++j) y[j] = bg[j] * (p.w_conv[c + j] * z2[j] + p.w_conv[512 + c + j] * z1[j] + p.w_conv[1024 + c + j] * z[j]);
        o.x = cvt_pk_bf16(y[0], y[1]); o.y = cvt_pk_bf16(y[2], y[3]); o.z = cvt_pk_bf16(y[4], y[5]); o.w = cvt_pk_bf16(y[6], y[7]);
        *(uint4*)(mA + (size_t)row * DM + 512 + c) = o;
    }
}

__global__ __launch_bounds__(512, 2) void fwd_megakernel(Params p) {
    extern __shared__ __attribute__((aligned(16))) unsigned char shm[];
    __shared__ uint4 xb_words;
    cg::grid_group grid = cg::this_grid();
    LAS unsigned char* lds = (LAS unsigned char*)shm;
    const int tid = fresh_tid(), G = gridDim.x, bid = blockIdx.x;
    if (tid == 0) xb_words = make_uint4(0u, 0u, 0u, 0u);
    __syncthreads();
    const XcdBarrier xb = xcd_barrier_post((unsigned*)(p.ws + WS_BAR), (volatile LAS unsigned*)&xb_words);
    bf16_t* WinT = (bf16_t*)(p.ws + WS_WIN); bf16_t* WoutT = (bf16_t*)(p.ws + WS_WOUT); bf16_t* Wff1T = (bf16_t*)(p.ws + WS_WFF1); bf16_t* Wff2T = (bf16_t*)(p.ws + WS_WFF2);
    bf16_t* WadaT = (bf16_t*)(p.ws + WS_WADA); bf16_t* Sb = (bf16_t*)(p.ws + WS_S);
    bf16_t* H = (bf16_t*)(p.ws + WS_H); bf16_t* mA = (bf16_t*)(p.ws + WS_MA); bf16_t* T = (bf16_t*)(p.ws + WS_R);
    float* mod = (float*)(p.ws + WS_MOD);
    { unsigned* cs = (unsigned*)(p.ws + WS_CNT) + CNT_S * 64;
      for (int i = bid * 512 + tid; i < 144 * DM / 8; i += G * 512) { const int b = i >> 7, k = (i & 127) * 8; uint4 o = {0u, 0u, 0u, 0u};
          if (b < NB) { const float* cp = (b < 8 ? p.c_prompt + (size_t)b * DM : p.c_sample + (size_t)(b - 8) * DM) + k; const f32x4 c0 = *(const f32x4*)cp, c1 = *(const f32x4*)(cp + 4);
              o.x = cvt_pk_bf16(silu_f(c0[0]), silu_f(c0[1])); o.y = cvt_pk_bf16(silu_f(c0[2]), silu_f(c0[3])); o.z = cvt_pk_bf16(silu_f(c1[0]), silu_f(c1[1])); o.w = cvt_pk_bf16(silu_f(c1[2]), silu_f(c1[3])); }
          *(uint4*)(Sb + (size_t)b * DM + k) = o; }
      if (bid < 144 * DM / 8 / 512) { asm volatile("s_waitcnt vmcnt(0)" ::: "memory"); __syncthreads();
          if (fresh_tid() == 0) { __builtin_amdgcn_fence(__ATOMIC_RELEASE, "agent"); asm volatile("s_waitcnt vmcnt(0)" ::: "memory"); xb_add(cs, 1u); } }
      bf16_t* Wt = (bf16_t*)(p.ws + WS_WTRIL);
      for (int i = bid * 512 + tid; i < 8 * 128 * 128; i += G * 512) { const int t = (i >> 7) & 127, s = i & 127; Wt[i] = (bf16_t)(cvt_pk_bf16(s <= t ? p.w_s[i] : 0.f, 0.f) & 0xffffu); }
      { int ctr = 0;
        transpose_cvt<true, true>(p.w_in, WinT, DM, DIN, (float*)shm, ctr, bid, G);
        transpose_cvt<false, true>(p.w_out, WoutT, DM, DM, (float*)shm, ctr, bid, G);
        transpose_cvt<false, true>(p.w_ff2, Wff2T, DFF, DM, (float*)shm, ctr, bid, G);
        transpose_cvt<false, true>(p.w_ff1, Wff1T, DM, DFF, (float*)shm, ctr, bid, G); }
      if (p.use_cg_sync) grid.sync();
      asm volatile("s_waitcnt vmcnt(0)" ::: "memory"); __syncthreads();
      if (fresh_tid() == 0) { asm volatile("buffer_inv sc1" ::: "memory"); spin_until(cs, 144 * DM / 8 / 512); asm volatile("s_waitcnt vmcnt(0)" ::: "memory"); }
      __syncthreads();
      mod_phase(p, Sb, (float*)shm); }
    xcd_barrier(xb);
    for (int rep = 0; rep < ((DUP >> 2) & 1) + 1; ++rep) {
    p1_prompt_rows(p);
    rownorm_phase<false>(p, p.g_mix, 0, 1024, false, NP, NTOK);
    }
    xcd_barrier(xb);
    { StaticOrder S; S.init(NP, DIN, G, bid, WGM_G1); Gemm g{H, WinT, NP, DIN, DM};
      EpiIn E{(bf16_t*)(p.ws + WS_PU), (bf16_t*)(p.ws + WS_PV), (bf16_t*)(p.ws + WS_PBG), (bf16_t*)(p.ws + WS_PZ), p.g_v, p.out};
      gemm_phase(lds, g, S, E);
      if (DUP & 8) gemm_phase(lds, g, S, E);
      small_gemm(H + (size_t)NP * DM, 8, WinT, DIN, DM, E, NP, (float*)shm, G == 256 ? bid - 128 : bid, G == 256 ? 128 : G);
      { const int blk = G == 256 ? bid - 128 : bid, nblk = G == 256 ? 128 : G;
        if (blk >= 0) { int ctr = 0;

 } } }
    xcd_barrier(xb);
    for (int rep = 0; rep < ((DUP >> 4) & 1) + 1; ++rep) {
    mixer_phase(p, shm);
    }
    xcd_barrier(xb);
    { StaticOrder S; S.init(NP, DM, G, bid); Gemm g{mA, WoutT, NP, DM, DM};
      EpiRes E{p.x_prompt, p.x_sample, mod, p.out, 2048, 0};
#if FUSE4
      EpiFused<0> EF{p.x_prompt, mod, p.g_ffn, p.out, H, (float*)(p.ws + WS_SLOT), (unsigned*)(p.ws + WS_CNT) + CNT_P4 * 64, (bf16_t*)(p.ws + WS_X1B)};
      gemm_phase(lds, g, S, EF, (float*)shm);
#else
      gemm_phase(lds, g, S, E);
#endif
      small_gemm_w<4, 8>(mA + (size_t)NP * DM, 8, WoutT, DM, DM, E, NP, (float*)shm); }
    xcd_barrier(xb);
#if !FUSE4
    rownorm_phase<false>(p, p.g_ffn, 3072, 4096, true);
    xcd_barrier(xb);
#endif
    { unsigned* ready6 = (unsigned*)(p.ws + WS_CNT) + CNT_READY6 * 64;
#if FUSE4
      if (bid < 16) {
          rownorm_phase<false>(p, p.g_ffn, 3072, 4096, true, NP, NTOK, 16);
          asm volatile("s_waitcnt vmcnt(0)" ::: "memory"); __syncthreads();
          if (fresh_tid() == 0) { __builtin_amdgcn_fence(__ATOMIC_RELEASE, "agent"); asm volatile("s_waitcnt vmcnt(0)" ::: "memory"); xb_add(ready6, 1u); } }
#endif
      StaticOrder S; S.init(NP, DFF, G, bid, WGM_G3); Gemm g{H, Wff1T, NP, DFF, DM};
      EpiRelu2 E{T};
      gemm_phase(lds, g, S, E);
#if FUSE4
      if (fresh_tid() == 0) { spin_until(ready6, 16u); __builtin_amdgcn_fence(__ATOMIC_ACQUIRE, "agent"); asm volatile("s_waitcnt vmcnt(0)" ::: "memory"); }
      __syncthreads();
#endif
      small_gemm_w<1, 16, true>(H + (size_t)NP * DM, 8, Wff1T, DFF, DM, E, NP, (float*)shm); }
    xcd_barrier(xb);
    { unsigned* done7 = (unsigned*)(p.ws + WS_CNT) + CNT_DONE7 * 64;
      StaticOrder S; S.init(NP, DM, G, bid); Gemm g{T, Wff2T, NP, DM, DFF};
      EpiRes E{p.x_prompt, p.x_sample, mod, p.out, 5120, 1};
#if FUSE7
      small_gemm_w<4, 16>(T + (size_t)NP * DFF, 8, Wff2T, DM, DFF, E, NP, (float*)shm);
      asm volatile("s_waitcnt vmcnt(0)" ::: "memory"); __syncthreads();
      if (fresh_tid() == 0) { __builtin_amdgcn_fence(__ATOMIC_RELEASE, "agent"); asm volatile("s_waitcnt vmcnt(0)" ::: "memory"); xb_add(done7, 1u); }
      EpiFused<1> EF{p.x_prompt, mod, p.g_final, p.out, H, (float*)(p.ws + WS_SLOT) + 64 * 4 * 256, (unsigned*)(p.ws + WS_CNT) + CNT_P7 * 64, (bf16_t*)(p.ws + WS_X1B)};
      gemm_phase(lds, g, S, EF, (float*)shm);
      if (bid < 16) {
          if (fresh_tid() == 0) { spin_until(done7, (unsigned)G); __builtin_amdgcn_fence(__ATOMIC_ACQUIRE, "agent"); asm volatile("s_waitcnt vmcnt(0)" ::: "memory"); }
          __syncthreads();
          rownorm_phase<true>(p, p.g_final, 0, 0, true, NP, NTOK, 16); }
#else
      gemm_phase(lds, g, S, E);
      small_gemm_w<4, 16>(T + (size_t)NP * DFF, 8, Wff2T, DM, DFF, E, NP, (float*)shm);
#endif
    }
#if !FUSE7
    xcd_barrier(xb);
    rownorm_phase<true>(p, p.g_final, 0, 0, true);
#endif
}

extern "C" void kernel_launch(void* const* d_in, const int* in_sizes, int n_in, void* d_out, int out_size, void* d_ws, size_t ws_size, hipStream_t stream) {
    static int grid = 0;
    if (grid == 0) {
        if (n_in != 18 || in_sizes[0] != NP * DM || (size_t)out_size != O_END || ws_size < WS_END) {
            fprintf(stderr, "kernel_launch: unexpected shapes (n_in %d, in0 %d, out %d, ws %zu, need %zu)\n", n_in, n_in > 0 ? in_sizes[0] : -1, out_size, ws_size, (size_t)WS_END); grid = -1; return; }
        int dev = 0, cus = 0, per_cu = 0;
        (void)hipGetDevice(&dev); (void)hipDeviceGetAttribute(&cus, hipDeviceAttributeMultiprocessorCount, dev);
        if (hipFuncSetAttribute((const void*)fwd_megakernel, hipFuncAttributeMaxDynamicSharedMemorySize, LDS_BYTES) != hipSuccess) { fprintf(stderr, "kernel_launch: hipFuncSetAttribute failed\n"); grid = -1; return; }
        if (hipOccupancyMaxActiveBlocksPerMultiprocessor(&per_cu, (const void*)fwd_megakernel, 512, LDS_BYTES) != hipSuccess || per_cu < 1) { fprintf(stderr, "kernel_launch: occupancy query failed (%d)\n", per_cu); grid = -1; return; }
        grid = cus * per_cu;
        if (grid != 256) { fprintf(stderr, "kernel_launch: built for 256 co-resident workgroups, got %d\n", grid); grid = -1; return; }
    }
    if (grid < 0) return;
    Params p{};
    p.x_prompt = (const float*)d_in[0]; p.x_sample = (const float*)d_in[1]; p.c_prompt = (const float*)d_in[2]; p.c_sample = (const float*)d_in[3]; p.state_conv = (const float*)d_in[4];
    p.g_mix = (const float*)d_in[5]; p.w_ada = (const float*)d_in[6]; p.b_ada = (const float*)d_in[7]; p.w_in = (const float*)d_in[8]; p.g_v = (const float*)d_in[9];
    p.w_s = (const float*)d_in[10]; p.b_s = (const float*)d_in[11]; p.w_conv = (const float*)d_in[12]; p.w_out = (const float*)d_in[13]; p.g_ffn = (const float*)d_in[14];
    p.w_ff1 = (const float*)d_in[15]; p.w_ff2 = (const float*)d_in[16]; p.g_final = (const float*)d_in[17];
    p.out = (float*)d_out; p.ws = (unsigned char*)d_ws;
    if (hipMemsetAsync((char*)d_ws + WS_BAR, 0, 16384 + CNT_BYTES, stream) != hipSuccess) { fprintf(stderr, "kernel_launch: memset failed\n"); return; }
    void* args[] = {&p};
    hipError_t e = hipLaunchCooperativeKernel((const void*)fwd_megakernel, dim3(grid), dim3(512), args, LDS_BYTES, stream);
    if (e != hipSuccess) fprintf(stderr, "cooperative launch failed: %s (grid %d)\n", hipGetErrorString(e), grid);
}
```

```cpp
#include <hip/hip_runtime.h>
#include <hip/hip_cooperative_groups.h>
#include <cstdio>
namespace cg = cooperative_groups;

#define LAS __attribute__((address_space(3)))
typedef unsigned short bf16_t;
typedef short bf16x8 __attribute__((ext_vector_type(8)));
typedef float f32x4 __attribute__((ext_vector_type(4)));

constexpr int DM = 1024, NP = 16384, NTOK = 16512, MPAD = 16640, NB = 136, NMOD = 6144, DIN = 2560, DFF = 4096;
constexpr int BM = 256, BK = 64, HALF = 128, HTB = HALF * BK * 2, STAGE_BYTES = 8 * HTB, NXCD = 8, WGM = 4;
constexpr int LDS_BYTES = STAGE_BYTES;
constexpr float EPS = 1e-6f;
#define WGM_G1 8
#define WGM_G3 4
#define DUP 0

constexpr size_t WS_WIN = 0;
constexpr size_t WS_WOUT = WS_WIN + (size_t)DIN * DM * 2;
constexpr size_t WS_WFF1 = WS_WOUT + (size_t)DM * DM * 2;
constexpr size_t WS_WFF2 = WS_WFF1 + (size_t)DFF * DM * 2;
constexpr size_t WS_WTRIL = WS_WFF2 + (size_t)DM * DFF * 2;
constexpr size_t WS_MOD = WS_WTRIL + (size_t)8 * 128 * 128 * 2;
constexpr size_t WS_H = WS_MOD + (size_t)NB * NMOD * 4;
constexpr size_t WS_R = WS_H + (size_t)MPAD * DM * 2;
constexpr size_t WS_PU = WS_R;
constexpr size_t WS_PV = WS_PU + (size_t)MPAD * 512 * 2;
constexpr size_t WS_PBG = WS_PV + (size_t)MPAD * 512 * 2;
constexpr size_t WS_PZ = WS_PBG + (size_t)MPAD * 512 * 2;
constexpr size_t WS_MA = WS_PZ + (size_t)MPAD * 512 * 2;
constexpr size_t WS_WADA = WS_R + (size_t)MPAD * DFF * 2;
constexpr size_t WS_S = WS_WADA + (size_t)NMOD * DM * 2;
constexpr size_t WS_BAR = WS_S + (size_t)144 * DM * 2;
constexpr size_t WS_CNT = WS_BAR + 16384;
constexpr int CNT_BYTES = 36864, CNT_P4 = 0, CNT_P7 = 64, CNT_READY6 = 128, CNT_DONE7 = 129, CNT_S = 130;
constexpr size_t WS_SLOT = WS_CNT + CNT_BYTES;
constexpr size_t WS_X1B = WS_SLOT + (size_t)2 * 64 * 4 * 256 * 4;
constexpr size_t WS_END = WS_X1B + (size_t)NP * DM * 2;
#define FUSE4 1
#define FUSE7 1
constexpr size_t O_Y = 0, O_CONVP = (size_t)NTOK * DM, O_CONVS = O_CONVP + 8 * 2 * 512, O_VS = O_CONVS + 128 * 2 * 512, O_END = O_VS + 128 * 512;

struct Params {
    const float *x_prompt, *x_sample, *c_prompt, *c_sample, *state_conv, *g_mix, *w_ada, *b_ada, *w_in, *g_v, *w_s, *b_s, *w_conv, *w_out, *g_ffn, *w_ff1, *w_ff2, *g_final;
    float* out; unsigned char* ws; int use_cg_sync; int pad0;
};

__device__ __forceinline__ unsigned cvt_pk_bf16(float lo, float hi) { unsigned r; asm("v_cvt_pk_bf16_f32 %0, %1, %2" : "=v"(r) : "v"(lo), "v"(hi)); return r; }
__device__ __forceinline__ float bf_lo(unsigned u) { return __uint_as_float(u << 16); }
__device__ __forceinline__ float bf_hi(unsigned u) { return __uint_as_float(u & 0xffff0000u); }
__device__ __forceinline__ float gelu_tanh(float x) { const float u = 1.5957691216f * (x + 0.044715f * x * x * x); return x * __builtin_amdgcn_rcpf(1.f + __expf(-u)); }
__device__ __forceinline__ float silu_f(float x) { return x * __builtin_amdgcn_rcpf(1.f + __expf(-x)); }
__device__ __forceinline__ void st_bf16x4(bf16_t* p, f32x4 v) { uint2 o; o.x = cvt_pk_bf16(v[0], v[1]); o.y = cvt_pk_bf16(v[2], v[3]); *(uint2*)p = o; }
__device__ __forceinline__ int batch_of(int row) { return row < NP ? (row >> 11) : (row < NTOK ? 8 + row - NP : NB - 1); }
union Frag { bf16x8 v; unsigned u[4]; uint4 q; };
__device__ __forceinline__ void unpack8(const uint4 q, float (&f)[8]) { f[0] = bf_lo(q.x); f[1] = bf_hi(q.x); f[2] = bf_lo(q.y); f[3] = bf_hi(q.y); f[4] = bf_lo(q.z); f[5] = bf_hi(q.z); f[6] = bf_lo(q.w); f[7] = bf_hi(q.w); }
__device__ __forceinline__ int fresh_tid() { int t = threadIdx.x; asm volatile("" : "+v"(t)); return t; }


#define XB_TMO      128
#define XB_XCNT(j)  (256  + 64 * (j))
#define XB_XSUB(j)  (1280 + 64 * (j))
#define XB_XGEN(j)  (2304 + 64 * (j))
#define XB_TOP      3328
#define XB_TOPGEN   3392
#define XCD_BAR_WORDS 3456
#define XB_SPIN_CAP (1u << 18)
__device__ __forceinline__ unsigned xb_ld(unsigned* p)              { return __hip_atomic_load(p, __ATOMIC_RELAXED, __HIP_MEMORY_SCOPE_AGENT); }
__device__ __forceinline__ unsigned xb_add(unsigned* p, unsigned v) { return __hip_atomic_fetch_add(p, v, __ATOMIC_RELAXED, __HIP_MEMORY_SCOPE_AGENT); }
__device__ __forceinline__ unsigned xb_xcc_id() { return (unsigned)__builtin_amdgcn_s_getreg((3 << 11) | 20) & 0xFu; }
#define XB_SPIN(cond, bar) do { unsigned _sp = 0; while (cond) { __builtin_amdgcn_s_sleep(1); \
    if ((++_sp & 255u) == 0u) { if (xb_ld(&(bar)[XB_TMO])) break; if (_sp > XB_SPIN_CAP) { atomicAdd(&(bar)[XB_TMO], 1u); break; } } } } while (0)
struct XcdBarrier { unsigned* bar; unsigned x; volatile LAS unsigned* st; };
__device__ __forceinline__ XcdBarrier xcd_barrier_post(unsigned* bar, volatile LAS unsigned* st) {
    XcdBarrier b; b.bar = bar; b.x = xb_xcc_id(); b.st = st;
    if (threadIdx.x == 0) (void)xb_add(&bar[XB_XCNT(b.x)], 1u);
    return b;
}
__device__ __forceinline__ void xcd_barrier_complete(unsigned* bar, unsigned x, unsigned& nloc, unsigned& nx) {
    const unsigned G = gridDim.x * gridDim.y * gridDim.z;
    unsigned sum, cnt, mine, sp = 0u;
    for (;;) {
        sum = 0u; cnt = 0u; mine = 0u;
#pragma unroll
        for (unsigned j = 0; j < 16; ++j) { const unsigned c = xb_ld(&bar[XB_XCNT(j)]); sum += c; cnt += (c > 0u) ? 1u : 0u; mine = (j == x) ? c : mine; }
        if (sum == G) break;
        __builtin_amdgcn_s_sleep(1);
        if ((++sp & 255u) == 0u) { if (xb_ld(&bar[XB_TMO])) break; if (sp > XB_SPIN_CAP) { atomicAdd(&bar[XB_TMO], 1u); break; } }
    }
    nloc = mine > 0u ? mine : 1u; nx = cnt > 0u ? cnt : 1u;
}
__device__ __forceinline__ void xcd_barrier(const XcdBarrier& b) {
    asm volatile("s_waitcnt vmcnt(0)" ::: "memory");
    __syncthreads();
    if (threadIdx.x == 0) {
        unsigned* bar = b.bar;
        __builtin_amdgcn_s_waitcnt(0);
        unsigned nloc = b.st[0], nx = b.st[1];
        if (nloc == 0u) { xcd_barrier_complete(bar, b.x, nloc, nx); b.st[0] = nloc; b.st[1] = nx; }
        const unsigned old = xb_add(&bar[XB_XSUB(b.x)], 1u);
        const unsigned gen = old / nloc;
        if (old + 1u == (gen + 1u) * nloc) {
            __builtin_amdgcn_fence(__ATOMIC_RELEASE, "agent");
            asm volatile("s_waitcnt vmcnt(0)" ::: "memory");
            const unsigned og = xb_add(&bar[XB_TOP], 1u);
            const unsigned tg = og / nx;
            asm volatile("buffer_inv sc1" ::: "memory");
            if (og + 1u == (tg + 1u) * nx) xb_add(&bar[XB_TOPGEN], 1u);
            else XB_SPIN(xb_ld(&bar[XB_TOPGEN]) == tg, bar);
            xb_add(&bar[XB_XGEN(b.x)], 1u);
            asm volatile("s_waitcnt vmcnt(0)" ::: "memory");
        } else {
            asm volatile("buffer_inv sc1" ::: "memory");
            XB_SPIN(xb_ld(&bar[XB_XGEN(b.x)]) == gen, bar);
            asm volatile("s_waitcnt vmcnt(0)" ::: "memory");
        }
    }
    __syncthreads();
}

__device__ __forceinline__ int lds_byte(int r, int c) { const int st = (r >> 4) * 2 + (c >> 5), rr = r & 15, cc = c & 31, ob = rr * 64 + cc * 2; return st * 1024 + (ob ^ (((ob >> 9) & 1) << 5)); }
__device__ __forceinline__ void stage_rc(int b, int& R, int& C) { const int st = b / 1024, sb = b % 1024, swz = sb ^ (((sb >> 9) & 1) << 5); R = (st >> 1) * 16 + swz / 64; C = (st & 1) * 32 + (swz % 64) / 2; }

__device__ __forceinline__ int perm32(int rho) { const int n = rho >> 4, i = rho & 15; return 8 * (i >> 2) + 4 * n + (i & 3); }
__device__ __forceinline__ void st_bf16x8(bf16_t* p, const f32x4 a, const f32x4 b) { uint4 o; o.x = cvt_pk_bf16(a[0], a[1]); o.y = cvt_pk_bf16(a[2], a[3]); o.z = cvt_pk_bf16(b[0], b[1]); o.w = cvt_pk_bf16(b[2], b[3]); *(uint4*)p = o; }
typedef unsigned u32x4w __attribute__((ext_vector_type(4)));
__device__ __forceinline__ void st_wt_f32x4(float* p, const f32x4 v) { asm volatile("global_store_dwordx4 %0, %1, off sc1\n\ts_nop 1" :: "v"(p), "v"(v) : "memory"); }
__device__ __forceinline__ void st_wt_bf16x8(bf16_t* p, const f32x4 a, const f32x4 b) { const u32x4w o = {cvt_pk_bf16(a[0], a[1]), cvt_pk_bf16(a[2], a[3]), cvt_pk_bf16(b[0], b[1]), cvt_pk_bf16(b[2], b[3])};
    asm volatile("global_store_dwordx4 %0, %1, off sc1\n\ts_nop 1" :: "v"(p), "v"(o) : "memory"); }
struct Unit { int pm, pn; };
struct Gemm { const bf16_t* A; const bf16_t* Bt; int M, N, K; };
struct StaticOrder {
    int nM, nN, nwg, G, c, wgm;
    __device__ void init(int M, int N, int G_, int c_, int wgm_ = WGM) { nM = M / BM; nN = N / BM; nwg = nM * nN; G = G_; c = c_; wgm = wgm_; }
    __device__ bool next(int i, Unit& u) const {
        const long L = (long)i * G + c; if (L >= nwg) return false;
        int wgid = (int)L; { const int q = nwg / NXCD, r = nwg % NXCD, xcd = wgid % NXCD, off = wgid / NXCD; wgid = (xcd < r ? xcd * (q + 1) : r * (q + 1) + (xcd - r) * q) + off; }
        const int nig = wgm * nN, gid = wgid / nig, fm = gid * wgm, gsz = (nM - fm) < wgm ? (nM - fm) : wgm;
        u.pm = fm + ((wgid % nig) % gsz); u.pn = (wgid % nig) / gsz; return true;
    }
};

#define EPI_MAIN_CALL \
    static constexpr bool AFTER_DRAIN = false; \
    __device__ __forceinline__ void operator()(const f32x4 (&acc)[2][2][4][2], const Unit& u, int wr, int wc, int fr, int fq) const { \
        const int rowb = u.pm * BM + wr * 64 + fr; \
        _Pragma("unroll") for (int ai = 0; ai < 2; ++ai) _Pragma("unroll") for (int m = 0; m < 4; ++m) { \
            const f32x4 a[2][2] = {{acc[ai][0][m][0], acc[ai][0][m][1]}, {acc[ai][1][m][0], acc[ai][1][m][1]}}; \
            row(a, rowb + ai * HALF + m * 16, u.pn, wc, fq); } }
struct EpiIn {
    bf16_t *pU, *pV, *pBG, *pZ; const float* g_v; float* out;
    __device__ __forceinline__ void row(const f32x4 (&a)[2][2], int row, int pn, int wc, int fq) const {
        if (pn < 2 || pn == 4 || pn == 5) {
            bf16_t* dst = (pn < 2 ? pU : pBG) + (size_t)row * 512 + (pn & 1) * 256 + wc * 32 + 8 * fq;
#pragma unroll
            for (int bj = 0; bj < 2; ++bj) { f32x4 v0 = a[bj][0], v1 = a[bj][1];
                if (pn < 2) {
#pragma unroll
                    for (int j = 0; j < 4; ++j) { v0[j] = gelu_tanh(v0[j]); v1[j] = gelu_tanh(v1[j]); } }
                st_bf16x8(dst + bj * HALF, v0, v1); }
        } else if (pn < 4) {
            const int head = (pn - 2) * 4 + wc;
            f32x4 g[2][2]; float ss = 0.f;
#pragma unroll
            for (int bj = 0; bj < 2; ++bj)
#pragma unroll
                for (int n = 0; n < 2; ++n)
#pragma unroll
                    for (int j = 0; j < 4; ++j) { const float t = gelu_tanh(a[bj][n][j]); g[bj][n][j] = t; ss += t * t; }
            ss += __shfl_xor(ss, 16); ss += __shfl_xor(ss, 32);
            const float rs = rsqrtf(ss * (1.f / 64.f) + EPS);
#pragma unroll
            for (int bj = 0; bj < 2; ++bj) { const int d = head * 64 + bj * 32 + 8 * fq;
                const f32x4 v0 = g[bj][0] * rs * *(const f32x4*)(g_v + d), v1 = g[bj][1] * rs * *(const f32x4*)(g_v + d + 4);
                st_bf16x8(pV + (size_t)row * 512 + d, v0, v1);
                if (row >= NP && row < NTOK) { float* o = out + O_VS + (size_t)(row - NP) * 512 + d; *(f32x4*)o = v0; *(f32x4*)(o + 4) = v1; } }
        } else {
            const int c = (pn - 6) * 128 + wc * 32 + 8 * fq;
            const f32x4 z0 = a[0][0] * a[1][0], z1 = a[0][1] * a[1][1];
            st_bf16x8(pZ + (size_t)row * 512 + c, z0, z1);
            float* o = nullptr;
            if (row < NP) { const int t = row & 2047; if (t >= 2046) o = out + O_CONVP + (size_t)((row >> 11) * 2 + (t - 2046)) * 512 + c; }
            else if (row < NTOK) o = out + O_CONVS + (size_t)((row - NP) * 2 + 1) * 512 + c;
            if (o) { *(f32x4*)o = z0; *(f32x4*)(o + 4) = z1; }
        }
    }
    EPI_MAIN_CALL
};
struct EpiRes {
    const float *xp, *xs, *mod; float* out; int gate_off; int inplace;
    __device__ __forceinline__ void row(const f32x4 (&a)[2][2], int row, int pn, int wc, int fq) const {
        if (row < NTOK) { const int cb = pn * BM + wc * 32 + 4 * fq;
            const float* gt = mod + (size_t)batch_of(row) * NMOD + gate_off; float* orow = out + (size_t)row * DM;
            const float* br = inplace ? orow : (row < NP ? xp + (size_t)row * DM : xs + (size_t)(row - NP) * DM);
#pragma unroll
            for (int bj = 0; bj < 2; ++bj)
#pragma unroll
                for (int n = 0; n < 2; ++n) { const int c = cb + bj * HALF + n * 16;
                    *(f32x4*)(orow + c) = *(const f32x4*)(br + c) + *(const f32x4*)(gt + c) * a[bj][n]; } }
    }
    __device__ __forceinline__ void frag(const f32x4 a, int row, int cs) const {
        const int c = (cs & ~31) + perm32(cs & 31);
        const float* gt = mod + (size_t)batch_of(row) * NMOD + gate_off; float* orow = out + (size_t)row * DM;
        const float* br = inplace ? orow : (row < NP ? xp + (size_t)row * DM : xs + (size_t)(row - NP) * DM);
        const f32x4 r = *(const f32x4*)(br + c) + *(const f32x4*)(gt + c) * a;
        if (inplace) st_wt_f32x4(orow + c, r); else *(f32x4*)(orow + c) = r; }
    EPI_MAIN_CALL
};
struct EpiRelu2 {
    bf16_t* T;
    __device__ __forceinline__ void row(const f32x4 (&a)[2][2], int row, int pn, int wc, int fq) const {
        bf16_t* rp = T + (size_t)row * DFF + pn * BM + wc * 32 + 8 * fq;
#pragma unroll
        for (int bj = 0; bj < 2; ++bj) { f32x4 v0 = a[bj][0], v1 = a[bj][1];
#pragma unroll
            for (int j = 0; j < 4; ++j) { const float r0 = fmaxf(v0[j], 0.f), r1 = fmaxf(v1[j], 0.f); v0[j] = r0 * r0; v1[j] = r1 * r1; }
            st_bf16x8(rp + bj * HALF, v0, v1); }
    }
    __device__ __forceinline__ void frag(f32x4 v, int row, int c) const {
#pragma unroll
        for (int j = 0; j < 4; ++j) { const float r = fmaxf(v[j], 0.f); v[j] = r * r; }
        st_bf16x4(T + (size_t)row * DFF + (c & ~31) + perm32(c & 31), v); }
    EPI_MAIN_CALL
};
struct EpiNull {
    float* sink; int flag;
    __device__ __forceinline__ void row(const f32x4 (&a)[2][2], int row, int pn, int wc, int fq) const {
        if (flag) { *(f32x4*)(sink + (size_t)row * DM + pn * BM + wc * 32 + 4 * fq) = a[0][0] + a[0][1] + a[1][0] + a[1][1]; } }
    EPI_MAIN_CALL
};
__device__ __forceinline__ void spin_until(unsigned* p, unsigned need) { unsigned sp = 0; while (xb_ld(p) < need) { __builtin_amdgcn_s_sleep(1); if (++sp > (1u << 20)) break; } }
template <int MODE>
struct EpiFused {
    static constexpr bool AFTER_DRAIN = true;
    const float *xp, *mod, *g; float* out; bf16_t* H; float* slots; unsigned* cnt; bf16_t* X1;
    __device__ __forceinline__ void fused(f32x4 (&acc)[2][2][4][2], const Unit& u, int wr, int wc, int fr, int fq, float* smem) const {
        const int tid = fresh_tid();
        const float* mb = mod + (size_t)(u.pm >> 3) * NMOD;
        const int cb = u.pn * BM + wc * 32 + 8 * fq, rl0 = wr * 64 + fr;
        float* part = smem; float* rsv = smem + 1024;
        f32x4 gt[2][2];
#pragma unroll
        for (int bj = 0; bj < 2; ++bj)
#pragma unroll
            for (int n = 0; n < 2; ++n) gt[bj][n] = *(const f32x4*)(mb + (MODE ? 5120 : 2048) + cb + bj * HALF + n * 4);
#pragma unroll
        for (int ai = 0; ai < 2; ++ai) {
            f32x4 bs[4][2][2];
#pragma unroll
            for (int m = 0; m < 4; ++m) { const size_t ro = (size_t)(u.pm * BM + rl0 + ai * HALF + m * 16) * DM;
#pragma unroll
                for (int bj = 0; bj < 2; ++bj)
#pragma unroll
                    for (int n = 0; n < 2; ++n) { const int c = cb + bj * HALF + n * 4;
                        if (MODE) { const uint2 q = *(const uint2*)(X1 + ro + c); bs[m][bj][n] = (f32x4){bf_lo(q.x), bf_hi(q.x), bf_lo(q.y), bf_hi(q.y)}; }
                        else bs[m][bj][n] = *(const f32x4*)(xp + ro + c); } }
            __builtin_amdgcn_sched_barrier(0);
#pragma unroll
            for (int m = 0; m < 4; ++m) { float ss = 0.f;
#pragma unroll
                for (int bj = 0; bj < 2; ++bj)
#pragma unroll
                    for (int n = 0; n < 2; ++n) { const f32x4 v = bs[m][bj][n] + gt[bj][n] * acc[ai][bj][m][n]; acc[ai][bj][m][n] = v; ss += v[0] * v[0] + v[1] * v[1] + v[2] * v[2] + v[3] * v[3]; }
                ss += __shfl_xor(ss, 16); ss += __shfl_xor(ss, 32);
                if (fq == 0) part[(rl0 + ai * HALF + m * 16) * 4 + wc] = ss; } }
        __syncthreads();
        if (tid < 256) { const f32x4 q = *(const f32x4*)(part + tid * 4); __hip_atomic_store(slots + (size_t)(u.pm * 4 + u.pn) * 256 + tid, (q[0] + q[1]) + (q[2] + q[3]), __ATOMIC_RELAXED, __HIP_MEMORY_SCOPE_AGENT); }
        asm volatile("s_waitcnt vmcnt(0)" ::: "memory");
        __syncthreads();
        if (tid == 0) { xb_add(cnt + u.pm * 64, 1u); spin_until(cnt + u.pm * 64, 4u); }
        f32x4 gs[2][2], sh[2][2];
#pragma unroll
        for (int bj = 0; bj < 2; ++bj)
#pragma unroll
            for (int n = 0; n < 2; ++n) { const int c = cb + bj * HALF + n * 4; gs[bj][n] = *(const f32x4*)(g + c);
                if (MODE == 0) { gs[bj][n] = gs[bj][n] * (*(const f32x4*)(mb + 4096 + c) + 1.f); sh[bj][n] = *(const f32x4*)(mb + 3072 + c); } }
        __syncthreads();
        if (tid < 256) { float s = 0.f;
#pragma unroll
            for (int q = 0; q < 4; ++q) s += __hip_atomic_load(slots + (size_t)(u.pm * 4 + q) * 256 + tid, __ATOMIC_RELAXED, __HIP_MEMORY_SCOPE_AGENT);
            rsv[tid] = rsqrtf(s * (1.f / DM) + EPS); }
        __syncthreads();
#pragma unroll
        for (int ai = 0; ai < 2; ++ai)
#pragma unroll
            for (int m = 0; m < 4; ++m) { const int rl = rl0 + ai * HALF + m * 16; const size_t ro = (size_t)(u.pm * BM + rl) * DM; const float r = rsv[rl];
#pragma unroll
                for (int bj = 0; bj < 2; ++bj) { const int c = cb + bj * HALF; const f32x4 v0 = acc[ai][bj][m][0], v1 = acc[ai][bj][m][1];
                    if (MODE == 0) { st_bf16x8(X1 + ro + c, v0, v1); st_bf16x8(H + ro + c, v0 * r * gs[bj][0] + sh[bj][0], v1 * r * gs[bj][1] + sh[bj][1]); }
                    else { *(f32x4*)(out + ro + c) = v0 * r * gs[bj][0]; *(f32x4*)(out + ro + c + 4) = v1 * r * gs[bj][1]; } } }
        __syncthreads();
    }
};
struct EpiMod {
    float* mod; const float* b_ada;
    __device__ __forceinline__ void frag(const f32x4 a, int row, int c) const { if (row < NB) *(f32x4*)(mod + (size_t)row * NMOD + c) = a + *(const f32x4*)(b_ada + c); }
    __device__ __forceinline__ void row(const f32x4 (&a)[2][2], int row, int pn, int wc, int fq) const {
        if (row < NB) { const int cb = pn * BM + wc * 32 + 4 * fq;
#pragma unroll
            for (int bj = 0; bj < 2; ++bj)
#pragma unroll
                for (int n = 0; n < 2; ++n) { const int c = cb + bj * HALF + n * 16; *(f32x4*)(mod + (size_t)row * NMOD + c) = a[bj][n] + *(const f32x4*)(b_ada + c); } }
    }
};

template <class Epi>
__device__ __forceinline__ void small_gemm(const bf16_t* __restrict__ A, int nm16, const bf16_t* __restrict__ Bt, int N, int K, const Epi& E, int row_base, float* smem, int blk, int nblk) {
    if (blk < 0) return;
    const int tid = fresh_tid(), w = tid >> 6, lane = tid & 63, fr = lane & 15, fq = lane >> 4;
    const int ntasks = (N / 256) * 4 * nm16, kw = K / 8;
    f32x4* red = (f32x4*)smem;
    for (int t = blk; t < ntasks; t += nblk) {
        const int m16 = t % nm16, r = t / nm16, wc = r & 3, pn = r >> 2;
        const bf16_t* ap = A + (size_t)(m16 * 16 + fr) * K + w * kw + fq * 8;
        const bf16_t* bp = Bt + (size_t)(pn * 256 + wc * 32 + fr) * K + w * kw + fq * 8;
        f32x4 acc[2][2] = {{{0.f, 0.f, 0.f, 0.f}, {0.f, 0.f, 0.f, 0.f}}, {{0.f, 0.f, 0.f, 0.f}, {0.f, 0.f, 0.f, 0.f}}};
#pragma unroll 4
        for (int ks = 0; ks < kw / 32; ++ks) {
            Frag a; a.q = *(const uint4*)(ap + ks * 32);
#pragma unroll
            for (int bj = 0; bj < 2; ++bj)
#pragma unroll
                for (int n = 0; n < 2; ++n) { Frag b; b.q = *(const uint4*)(bp + (size_t)(bj * 128 + n * 16) * K + ks * 32);
                    acc[bj][n] = __builtin_amdgcn_mfma_f32_16x16x32_bf16(b.v, a.v, acc[bj][n], 0, 0, 0); }
        }
#pragma unroll
        for (int i = 0; i < 4; ++i) red[(w * 4 + i) * 64 + lane] = acc[i >> 1][i & 1];
        __syncthreads();
        if (w == 0) { f32x4 s[2][2];
#pragma unroll
            for (int i = 0; i < 4; ++i) { f32x4 v = red[i * 64 + lane];
#pragma unroll
                for (int w2 = 1; w2 < 8; ++w2) v += red[(w2 * 4 + i) * 64 + lane];
                s[i >> 1][i & 1] = v; }
            E.row(s, row_base + m16 * 16 + fr, pn, wc, fq); }
        __syncthreads();
    }
}


template <int KSPLIT, int BATCH, bool SHAREB = false, class Epi>
__device__ __forceinline__ void small_gemm_w(const bf16_t* __restrict__ A, int nm16, const bf16_t* __restrict__ Bt, int N, int K, const Epi& E, int row_base, float* smem) {
    const int tid = fresh_tid(), w = tid >> 6, lane = tid & 63, fr = lane & 15, fq = lane >> 4;
    const int total = nm16 * (N / 16) * KSPLIT, kw = K / KSPLIT;
    f32x4* red = (f32x4*)smem;
    for (int base = blockIdx.x * 8; base < total; base += gridDim.x * 8) {
        const int task = base + w; const bool valid = task < total;
        const int tile = task / KSPLIT, ks = task % KSPLIT, m16 = tile % nm16, n16 = tile / nm16;
        f32x4 acc = {0.f, 0.f, 0.f, 0.f};
        if (KSPLIT == 1 && SHAREB) {
            __syncthreads();
            uint4* Bs = (uint4*)smem; const int nst = kw / 32, per = nst / 8;
            const bf16_t* bpb = Bt + (size_t)((base / nm16) * 16 + fr) * K + fq * 8;
            for (int j = 0; j < per; ++j) { const int s = w * per + j; Bs[s * 64 + lane] = *(const uint4*)(bpb + s * 32); }
            __syncthreads();
            if (valid) {
                const bf16_t* ap = A + (size_t)(m16 * 16 + fr) * K + fq * 8;
                for (int s0 = 0; s0 < nst; s0 += BATCH) { Frag a[BATCH];
#pragma unroll
                    for (int i = 0; i < BATCH; ++i) a[i].q = *(const uint4*)(ap + (s0 + i) * 32);
                    __builtin_amdgcn_sched_barrier(0);
#pragma unroll
                    for (int i = 0; i < BATCH; ++i) { Frag b; b.q = Bs[(s0 + i) * 64 + lane]; acc = __builtin_amdgcn_mfma_f32_16x16x32_bf16(b.v, a[i].v, acc, 0, 0, 0); }
                    __builtin_amdgcn_sched_barrier(0); } }
            __syncthreads();
        } else if (valid) {
            const bf16_t* ap = A + (size_t)(m16 * 16 + fr) * K + ks * kw + fq * 8;
            const bf16_t* bp = Bt + (size_t)(n16 * 16 + fr) * K + ks * kw + fq * 8;
            for (int s0 = 0; s0 < kw / 32; s0 += BATCH) { Frag a[BATCH], b[BATCH];
#pragma unroll
                for (int i = 0; i < BATCH; ++i) { a[i].q = *(const uint4*)(ap + (s0 + i) * 32); b[i].q = *(const uint4*)(bp + (s0 + i) * 32); }
                __builtin_amdgcn_sched_barrier(0);
#pragma unroll
                for (int i = 0; i < BATCH; ++i) acc = __builtin_amdgcn_mfma_f32_16x16x32_bf16(b[i].v, a[i].v, acc, 0, 0, 0);
                __builtin_amdgcn_sched_barrier(0); }
        }
        if (KSPLIT > 1) {
            red[w * 64 + lane] = acc;
            __syncthreads();
            if (ks == 0) {
#pragma unroll
                for (int j = 1; j < KSPLIT; ++j) acc += red[(w + j) * 64 + lane]; }
        }
        if (valid && ks == 0) E.frag(acc, row_base + m16 * 16 + fr, n16 * 16 + 4 * fq);
        if (KSPLIT > 1) __syncthreads();
    }
}

template <class Epi>
__device__ __forceinline__ void gemm_phase(LAS unsigned char* lds, const Gemm g, const StaticOrder& S, const Epi& E, float* smem = nullptr) {
    const int tid = fresh_tid(), wid = __builtin_amdgcn_readfirstlane(tid >> 6), lane = tid & 63, wr = wid >> 2, wc = wid & 3, fr = lane & 15, fq = lane >> 4;
    const int K = g.K, nt = K / BK;
    unsigned voffA[2];
#pragma unroll
    for (int i = 0; i < 2; ++i) { int R, C; stage_rc(tid * 16 + i * 8192, R, C); voffA[i] = (unsigned)(R * K + C) * 2u; }
    const size_t kstep = (size_t)(BK * 2), hstep = (size_t)HALF * K * 2, tstep = 2 * hstep;
    const unsigned ldsw = (unsigned)wid * 1024u;
    const int aoff = lds_byte(wr * 64 + fr, fq * 8), boff = lds_byte(wc * 32 + fr, fq * 8);
#define PG8_SA(b, h) (((b) * 2 + (h)) * HTB)
#define PG8_SB(b, h) ((4 + (b) * 2 + (h)) * HTB)
#define PG8_STAGE(bufoff, gbase, voff) do { _Pragma("unroll") for (int _i = 0; _i < 2; ++_i) \
        __builtin_amdgcn_global_load_lds((const unsigned*)((const char*)(gbase) + (voff)[_i]), (LAS unsigned*)(lds + (bufoff) + ldsw + _i * 8192), 16, 0, 0); } while (0)
#define PG8_LDA(dst, b, h) do { _Pragma("unroll") for (int m = 0; m < 4; ++m) _Pragma("unroll") for (int k = 0; k < 2; ++k) dst[m][k] = *(const LAS bf16x8*)(lds + PG8_SA(b, h) + aoff + m * 2048 + k * 1024); } while (0)
#define PG8_LDB(dst, b, h) do { _Pragma("unroll") for (int n = 0; n < 2; ++n) _Pragma("unroll") for (int k = 0; k < 2; ++k) dst[n][k] = *(const LAS bf16x8*)(lds + PG8_SB(b, h) + boff + n * 2048 + k * 1024); } while (0)
#define PG8_MMA(ai, bj, At, Bt) do { __builtin_amdgcn_s_setprio(1); _Pragma("unroll") for (int m = 0; m < 4; ++m) _Pragma("unroll") for (int n = 0; n < 2; ++n) _Pragma("unroll") for (int k = 0; k < 2; ++k) \
        acc[ai][bj][m][n] = __builtin_amdgcn_mfma_f32_16x16x32_bf16(Bt[n][k], At[m][k], acc[ai][bj][m][n], 0, 0, 0); __builtin_amdgcn_s_setprio(0); } while (0)
#define PG8_WAIT_V(n) asm volatile("s_waitcnt vmcnt(" #n ")" ::: "memory")
#define PG8_WAIT_L(n) asm volatile("s_waitcnt lgkmcnt(" #n ")" ::: "memory")
#define PG8_BAR __builtin_amdgcn_s_barrier()
#define PG8_SCHED __builtin_amdgcn_sched_barrier(0)
    Unit cur, nxt; int ui = 0;
    if (!S.next(0, cur)) return;
    f32x4 acc[2][2][4][2];
#pragma unroll
    for (int a = 0; a < 2; ++a)
#pragma unroll
        for (int b = 0; b < 2; ++b)
#pragma unroll
            for (int m = 0; m < 4; ++m)
#pragma unroll
                for (int n = 0; n < 2; ++n) acc[a][b][m][n] = (f32x4){0.f, 0.f, 0.f, 0.f};
    bf16x8 At[4][2], B0[2][2], B1[2][2];
    const char* cA = (const char*)g.A + (size_t)cur.pm * tstep; const char* cB = (const char*)g.Bt + (size_t)cur.pn * tstep;
    PG8_STAGE(PG8_SB(0, 0), cB, voffA); PG8_STAGE(PG8_SA(0, 0), cA, voffA); PG8_STAGE(PG8_SB(0, 1), cB + hstep, voffA); PG8_STAGE(PG8_SA(0, 1), cA + hstep, voffA);
    if (wr == 1) PG8_BAR;
    PG8_WAIT_V(4); PG8_BAR;
    PG8_STAGE(PG8_SB(1, 0), cB + kstep, voffA); PG8_STAGE(PG8_SA(1, 0), cA + kstep, voffA); PG8_STAGE(PG8_SB(1, 1), cB + hstep + kstep, voffA);
    PG8_WAIT_V(6); PG8_BAR;
    for (;;) {
        const bool has_next = S.next(ui + 1, nxt);
        const char* nA = has_next ? (const char*)g.A + (size_t)nxt.pm * tstep : cA; const char* nB = has_next ? (const char*)g.Bt + (size_t)nxt.pn * tstep : cB;
        for (int t = 0; t < nt; t += 2) {
            const bool last = (t == nt - 2);
            const char* a1 = cA + (size_t)(t + 1) * kstep;
            const char* a2 = last ? nA : cA + (size_t)(t + 2) * kstep; const char* b2 = last ? nB : cB + (size_t)(t + 2) * kstep;
            const char* a3 = a2 + kstep; const char* b3 = b2 + kstep;
            PG8_LDB(B0, 0, 0); PG8_SCHED; PG8_LDA(At, 0, 0); PG8_STAGE(PG8_SA(1, 1), a1 + hstep, voffA);
            PG8_WAIT_L(8); PG8_BAR; PG8_WAIT_L(0); PG8_MMA(0, 0, At, B0); PG8_BAR; PG8_SCHED;
            PG8_LDB(B1, 0, 1); PG8_STAGE(PG8_SB(0, 0), b2, voffA);
            PG8_BAR; PG8_WAIT_L(0); PG8_MMA(0, 1, At, B1); PG8_BAR;
            PG8_LDA(At, 0, 1); PG8_STAGE(PG8_SA(0, 0), a2, voffA);
            PG8_BAR; PG8_WAIT_L(0); PG8_MMA(1, 0, At, B0); PG8_BAR; PG8_SCHED;
            PG8_STAGE(PG8_SB(0, 1), b2 + hstep, voffA);
            PG8_WAIT_V(6); PG8_BAR; PG8_MMA(1, 1, At, B1); PG8_BAR;
            PG8_LDB(B0, 1, 0); PG8_SCHED; PG8_LDA(At, 1, 0); PG8_STAGE(PG8_SA(0, 1), a2 + hstep, voffA);
            PG8_WAIT_L(8); PG8_BAR; PG8_WAIT_L(0); PG8_MMA(0, 0, At, B0); PG8_BAR; PG8_SCHED;
            PG8_LDB(B1, 1, 1); PG8_STAGE(PG8_SB(1, 0), b3, voffA);
            PG8_BAR; PG8_WAIT_L(0); PG8_MMA(0, 1, At, B1); PG8_BAR;
            PG8_LDA(At, 1, 1); PG8_STAGE(PG8_SA(1, 0), a3, voffA);
            PG8_BAR; PG8_WAIT_L(0); PG8_MMA(1, 0, At, B0); PG8_BAR; PG8_SCHED;
            PG8_STAGE(PG8_SB(1, 1), b3 + hstep, voffA);
            PG8_WAIT_V(6); PG8_BAR; PG8_MMA(1, 1, At, B1); PG8_BAR;
        }
        if constexpr (!Epi::AFTER_DRAIN) E(acc, cur, wr, wc, fr, fq);
        if (!has_next) break;
#pragma unroll
        for (int a = 0; a < 2; ++a)
#pragma unroll
            for (int b = 0; b < 2; ++b)
#pragma unroll
                for (int m = 0; m < 4; ++m)
#pragma unroll
                    for (int n = 0; n < 2; ++n) acc[a][b][m][n] = (f32x4){0.f, 0.f, 0.f, 0.f};
        cur = nxt; cA = nA; cB = nB; ++ui;
    }
    PG8_WAIT_V(0);
    if (wr == 0) PG8_BAR;
    PG8_BAR;
    if constexpr (Epi::AFTER_DRAIN) E.fused(acc, cur, wr, wc, fr, fq, smem);
#undef PG8_SA
#undef PG8_SB
#undef PG8_STAGE
#undef PG8_LDA
#undef PG8_LDB
#undef PG8_MMA
#undef PG8_WAIT_V
#undef PG8_WAIT_L
#undef PG8_BAR
#undef PG8_SCHED
}

__device__ __forceinline__ int win_src_col(int np) {
    const int tile = np >> 8, s = np & 255;
    if (tile < 2 || tile == 4 || tile == 5) return np;
    if (tile < 4) { const int bj = s >> 7, wc = (s >> 5) & 3, i = s & 31; return 512 + (tile - 2) * 256 + wc * 64 + bj * 32 + i; }
    return 1536 + (s >> 7) * 512 + (tile - 6) * 128 + (s & 127);
}
template <bool PERMW, bool PERM32>
__device__ __forceinline__ void transpose_cvt(const float* __restrict__ src, bf16_t* __restrict__ dst, int K, int N, float* T, int& tile_ctr, int blk, int nblk) {
    const int tid = fresh_tid(), nkt = K / 64, ntiles = nkt * (N / 256);
    int tl0 = (blk - tile_ctr) % nblk; if (tl0 < 0) tl0 += nblk;
    tile_ctr += ntiles;
    for (int tl = tl0; tl < ntiles; tl += nblk) {
        const int k0 = (tl % nkt) * 64, n0 = (tl / nkt) * 256;
        { const int n4 = (tid & 63) * 4, sc = PERMW ? win_src_col(n0 + n4) : n0 + n4; f32x4 v[8];
#pragma unroll
          for (int i = 0; i < 8; ++i) { const int k = (tid >> 6) + 8 * i; v[i] = *(const f32x4*)(src + (size_t)(k0 + k) * N + sc); }
#pragma unroll
          for (int i = 0; i < 8; ++i) { const int k = (tid >> 6) + 8 * i; *(f32x4*)(T + k * 256 + (n4 ^ (((k >> 3) & 7) << 2))) = v[i]; } }
        __syncthreads();
#pragma unroll
        for (int i = 0; i < 4; ++i) { const int pi = tid + 512 * i, q = pi & 7, nl = pi >> 3, x = PERM32 ? (nl & ~31) + perm32(nl & 31) : nl; const float* tp = T + (8 * q) * 256 + (x ^ (q << 2)); uint4 o;
            o.x = cvt_pk_bf16(tp[0], tp[256]); o.y = cvt_pk_bf16(tp[512], tp[768]); o.z = cvt_pk_bf16(tp[1024], tp[1280]); o.w = cvt_pk_bf16(tp[1536], tp[1792]);
            *(uint4*)(dst + (size_t)(n0 + nl) * K + k0 + 8 * q) = o; }
        __syncthreads();
    }
}
__device__ __forceinline__ void mod_phase(const Params& p, const bf16_t* __restrict__ Sb, float* smem) {
    const int tid = fresh_tid(), w = tid >> 6, lane = tid & 63, fr = lane & 15, fq = lane >> 4;
    f32x4* red = (f32x4*)smem; float* mod = (float*)(p.ws + WS_MOD);
    for (int it = blockIdx.x; it < NMOD / 32; it += gridDim.x) {
        const int col0 = it * 32;
        f32x4 acc[2][9];
#pragma unroll
        for (int i = 0; i < 9; ++i) { acc[0][i] = (f32x4){0.f, 0.f, 0.f, 0.f}; acc[1][i] = (f32x4){0.f, 0.f, 0.f, 0.f}; }
        Frag wfA[4], wfB[4];
#pragma unroll
        for (int kk = 0; kk < 4; ++kk) { const float* wp = p.w_ada + (size_t)(w * 128 + kk * 32 + fq * 8) * NMOD + col0 + 2 * fr;
#pragma unroll
            for (int i = 0; i < 4; ++i) { const float2 v0 = *(const float2*)(wp + (size_t)(2 * i) * NMOD), v1 = *(const float2*)(wp + (size_t)(2 * i + 1) * NMOD);
                wfA[kk].u[i] = cvt_pk_bf16(v0.x, v1.x); wfB[kk].u[i] = cvt_pk_bf16(v0.y, v1.y); } }
#pragma unroll
        for (int kk = 0; kk < 4; ++kk) {
#pragma unroll
            for (int bt = 0; bt < 9; ++bt) { Frag sf; sf.q = *(const uint4*)(Sb + (size_t)(bt * 16 + fr) * DM + w * 128 + kk * 32 + fq * 8);
                acc[0][bt] = __builtin_amdgcn_mfma_f32_16x16x32_bf16(wfA[kk].v, sf.v, acc[0][bt], 0, 0, 0);
                acc[1][bt] = __builtin_amdgcn_mfma_f32_16x16x32_bf16(wfB[kk].v, sf.v, acc[1][bt], 0, 0, 0); } }
        if (w >= 4) {
#pragma unroll
            for (int bt = 0; bt < 9; ++bt) { red[((w - 4) * 18 + bt) * 64 + lane] = acc[0][bt]; red[((w - 4) * 18 + 9 + bt) * 64 + lane] = acc[1][bt]; } }
        __syncthreads();
        if (w < 4) {
#pragma unroll
            for (int bt = 0; bt < 9; ++bt) { acc[0][bt] += red[(w * 18 + bt) * 64 + lane]; acc[1][bt] += red[(w * 18 + 9 + bt) * 64 + lane]; } }
        __syncthreads();
        if (w < 4) {
#pragma unroll
            for (int bt = 0; bt < 9; ++bt) { red[(w * 18 + bt) * 64 + lane] = acc[0][bt]; red[(w * 18 + 9 + bt) * 64 + lane] = acc[1][bt]; } }
        __syncthreads();
        for (int idx = tid; idx < 9 * 64; idx += 512) { const int bt = idx >> 6, l = idx & 63; f32x4 sa = red[bt * 64 + l], sb = red[(9 + bt) * 64 + l];
#pragma unroll
            for (int w2 = 1; w2 < 4; ++w2) { sa += red[(w2 * 18 + bt) * 64 + l]; sb += red[(w2 * 18 + 9 + bt) * 64 + l]; }
            const int b = bt * 16 + (l & 15), j = col0 + (l >> 4) * 8;
            if (b < NB) { float* mp = mod + (size_t)b * NMOD + j;
                *(f32x4*)mp = (f32x4){sa[0], sb[0], sa[1], sb[1]} + *(const f32x4*)(p.b_ada + j);
                *(f32x4*)(mp + 4) = (f32x4){sa[2], sb[2], sa[3], sb[3]} + *(const f32x4*)(p.b_ada + j + 4); } }
        __syncthreads();
    }
}
template <bool FINAL, bool WT = false>
__device__ __forceinline__ void rownorm_phase(const Params& p, const float* g, int sh_off, int sc_off, bool from_out, int r0 = 0, int r1 = NTOK, int nblk = 0) {
    const int tid = fresh_tid(), lane = tid & 63, gw = blockIdx.x * 8 + (tid >> 6), nw = (nblk ? nblk : (int)gridDim.x) * 8;
    const float* mod = (const float*)(p.ws + WS_MOD); bf16_t* H = (bf16_t*)(p.ws + WS_H);
    f32x4 gv[4];
#pragma unroll
    for (int i = 0; i < 4; ++i) gv[i] = *(const f32x4*)(g + (i >> 1) * 512 + lane * 8 + (i & 1) * 4);
    for (int rowb = r0 + gw; rowb < r1; rowb += 4 * nw) {
        f32x4 v[4][4];
#pragma unroll
        for (int q = 0; q < 4; ++q) { const int row = rowb + q * nw;
            if (row < r1) { const float* src = from_out ? p.out + (size_t)row * DM : (row < NP ? p.x_prompt + (size_t)row * DM : p.x_sample + (size_t)(row - NP) * DM);
#pragma unroll
                for (int i = 0; i < 4; ++i) v[q][i] = *(const f32x4*)(src + (i >> 1) * 512 + lane * 8 + (i & 1) * 4); }
            else {
#pragma unroll
                for (int i = 0; i < 4; ++i) v[q][i] = (f32x4){0.f, 0.f, 0.f, 0.f}; } }
        __builtin_amdgcn_sched_barrier(0);
        float rs[4];
#pragma unroll
        for (int q = 0; q < 4; ++q) { float ss = 0.f;
#pragma unroll
            for (int i = 0; i < 4; ++i) ss += v[q][i][0] * v[q][i][0] + v[q][i][1] * v[q][i][1] + v[q][i][2] * v[q][i][2] + v[q][i][3] * v[q][i][3];
#pragma unroll
            for (int o = 1; o < 64; o <<= 1) ss += __shfl_xor(ss, o);
            rs[q] = rsqrtf(ss * (1.f / DM) + EPS); }
#pragma unroll
        for (int q = 0; q < 4; ++q) { const int row = rowb + q * nw;
            if (row < r1) { const float* mb = mod + (size_t)batch_of(row) * NMOD;
#pragma unroll
                for (int h = 0; h < 2; ++h) { const int c = h * 512 + lane * 8;
                    const f32x4 y0 = v[q][2 * h] * rs[q] * gv[2 * h], y1 = v[q][2 * h + 1] * rs[q] * gv[2 * h + 1];
                    if (FINAL) { *(f32x4*)(p.out + (size_t)row * DM + c) = y0; *(f32x4*)(p.out + (size_t)row * DM + c + 4) = y1; }
                    else { if (WT) st_wt_bf16x8(H + (size_t)row * DM + c, y0 * (*(const f32x4*)(mb + sc_off + c) + 1.f) + *(const f32x4*)(mb + sh_off + c),
                                                             y1 * (*(const f32x4*)(mb + sc_off + c + 4) + 1.f) + *(const f32x4*)(mb + sh_off + c + 4)); else st_bf16x8(H + (size_t)row * DM + c, y0 * (*(const f32x4*)(mb + sc_off + c) + 1.f) + *(const f32x4*)(mb + sh_off + c),
                                                             y1 * (*(const f32x4*)(mb + sc_off + c + 4) + 1.f) + *(const f32x4*)(mb + sh_off + c + 4)); } } } }
    }
}
__device__ __forceinline__ void p1_prompt_rows(const Params& p) {
    const int tid = fresh_tid(), lane = tid & 63, gw = blockIdx.x * 8 + (tid >> 6);
    const float* mb = (const float*)(p.ws + WS_MOD) + (size_t)(gw >> 8) * NMOD; bf16_t* H = (bf16_t*)(p.ws + WS_H);
    f32x4 gs[4], sh[4];
#pragma unroll
    for (int i = 0; i < 4; ++i) { const int c = (i >> 1) * 512 + lane * 8 + (i & 1) * 4; gs[i] = *(const f32x4*)(p.g_mix + c) * (*(const f32x4*)(mb + 1024 + c) + 1.f); sh[i] = *(const f32x4*)(mb + c); }
#pragma unroll
    for (int trip = 0; trip < 2; ++trip) { const int rowb = gw * 8 + trip * 4;
        f32x4 v[4][4];
#pragma unroll
        for (int q = 0; q < 4; ++q)
#pragma unroll
            for (int i = 0; i < 4; ++i) v[q][i] = *(const f32x4*)(p.x_prompt + (size_t)(rowb + q) * DM + (i >> 1) * 512 + lane * 8 + (i & 1) * 4);
        __builtin_amdgcn_sched_barrier(0);
#pragma unroll
        for (int q = 0; q < 4; ++q) { float ss = 0.f;
#pragma unroll
            for (int i = 0; i < 4; ++i) ss += v[q][i][0] * v[q][i][0] + v[q][i][1] * v[q][i][1] + v[q][i][2] * v[q][i][2] + v[q][i][3] * v[q][i][3];
#pragma unroll
            for (int o = 1; o < 64; o <<= 1) ss += __shfl_xor(ss, o);
            const float rs = rsqrtf(ss * (1.f / DM) + EPS);
#pragma unroll
            for (int h = 0; h < 2; ++h) st_bf16x8(H + (size_t)(rowb + q) * DM + h * 512 + lane * 8, v[q][2 * h] * rs * gs[2 * h] + sh[2 * h], v[q][2 * h + 1] * rs * gs[2 * h + 1] + sh[2 * h + 1]); }
    }
}
__device__ __forceinline__ void mixer_phase(const Params& p, unsigned char* smem) {
    const int tid = fresh_tid(), w = tid >> 6, lane = tid & 63, fr = lane & 15, fq = lane >> 4;
    const bf16_t* pU = (const bf16_t*)(p.ws + WS_PU); const bf16_t* pV = (const bf16_t*)(p.ws + WS_PV); const bf16_t* pBG = (const bf16_t*)(p.ws + WS_PBG); const bf16_t* pZ = (const bf16_t*)(p.ws + WS_PZ);
    bf16_t* mA = (bf16_t*)(p.ws + WS_MA); const bf16_t* Wt = (const bf16_t*)(p.ws + WS_WTRIL);
    bf16_t* Vs = (bf16_t*)smem;
    for (int item = blockIdx.x; item < 256; item += gridDim.x) {
        const int hh = item & 1, bc = item >> 1, row0 = (bc >> 4) * 2048 + (bc & 15) * 128;
#pragma unroll
        for (int i = 0; i < 8; ++i) { const int pi = tid + 512 * i, s = pi >> 5, c16 = pi & 31, hl = c16 >> 3, d = (c16 & 7) * 8;
            *(uint4*)(Vs + ((hl * 128 + s) * 72 + d)) = *(const uint4*)(pV + (size_t)(row0 + s) * 512 + hh * 256 + c16 * 8); }
        __syncthreads();
        const int hl = w >> 1, thalf = w & 1, head = hh * 4 + hl;
        f32x4 acc[4][4];
#pragma unroll
        for (int a = 0; a < 4; ++a)
#pragma unroll
            for (int b = 0; b < 4; ++b) acc[a][b] = (f32x4){0.f, 0.f, 0.f, 0.f};
#pragma unroll
        for (int ks = 0; ks < 4; ++ks) {
            if (ks < 2 + 2 * thalf) {
                Frag af[4];
#pragma unroll
                for (int mt = 0; mt < 4; ++mt) af[mt].q = *(const uint4*)(Wt + ((size_t)(head * 128 + thalf * 64 + mt * 16 + fr) * 128 + ks * 32 + fq * 8));
#pragma unroll
                for (int nt = 0; nt < 4; ++nt) { Frag bf; const bf16_t* vp = Vs + ((hl * 128 + ks * 32 + fq * 8) * 72 + (nt >> 1) * 32 + perm32((nt & 1) * 16 + fr));
#pragma unroll
                    for (int i = 0; i < 4; ++i) bf.u[i] = (unsigned)vp[(2 * i) * 72] | ((unsigned)vp[(2 * i + 1) * 72] << 16);
#pragma unroll
                    for (int mt = 0; mt < 4; ++mt) acc[mt][nt] = __builtin_amdgcn_mfma_f32_16x16x32_bf16(bf.v, af[mt].v, acc[mt][nt], 0, 0, 0); }
            }
        }
#pragma unroll
        for (int mt = 0; mt < 4; ++mt) { const int t = thalf * 64 + mt * 16 + fr, row = row0 + t; const float bias = p.b_s[head * 128 + t];
#pragma unroll
            for (int pp = 0; pp < 2; ++pp) { const int col = head * 64 + pp * 32 + fq * 8; float u[8]; unpack8(*(const uint4*)(pU + (size_t)row * 512 + col), u);
                f32x4 o0 = acc[mt][2 * pp] + bias, o1 = acc[mt][2 * pp + 1] + bias;
#pragma unroll
                for (int j = 0; j < 4; ++j) { o0[j] *= u[j]; o1[j] *= u[4 + j]; }
                st_bf16x8(mA + (size_t)row * DM + col, o0, o1); } }
        __syncthreads();
    }
    for (int idx = blockIdx.x * 512 + tid; idx < (NP / 8) * 64; idx += gridDim.x * 512) {
        const int row0 = (idx >> 6) * 8, c = (idx & 63) * 8, t0 = row0 & 2047;
        uint4 zq[10], bq[8];
#pragma unroll
        for (int i = 0; i < 10; ++i) { zq[i] = make_uint4(0u, 0u, 0u, 0u); if (i >= 2 || t0 > 0) zq[i] = *(const uint4*)(pZ + (size_t)(row0 + i - 2) * 512 + c); }
#pragma unroll
        for (int i = 0; i < 8; ++i) bq[i] = *(const uint4*)(pBG + (size_t)(row0 + i) * 512 + c);
        float w0[8], w1[8], w2[8];
#pragma unroll
        for (int j = 0; j < 8; ++j) { w0[j] = p.w_conv[c + j]; w1[j] = p.w_conv[512 + c + j]; w2[j] = p.w_conv[1024 + c + j]; }
#pragma unroll
        for (int i = 0; i < 8; ++i) { float za[8], zb[8], zc[8], bg[8], y[8];
            unpack8(zq[i], za); unpack8(zq[i + 1], zb); unpack8(zq[i + 2], zc); unpack8(bq[i], bg);
#pragma unroll
            for (int j = 0; j < 8; ++j) y[j] = bg[j] * (w0[j] * za[j] + w1[j] * zb[j] + w2[j] * zc[j]);
            uint4 o; o.x = cvt_pk_bf16(y[0], y[1]); o.y = cvt_pk_bf16(y[2], y[3]); o.z = cvt_pk_bf16(y[4], y[5]); o.w = cvt_pk_bf16(y[6], y[7]);
            *(uint4*)(mA + (size_t)(row0 + i) * DM + 512 + c) = o; }
    }
    for (int idx = blockIdx.x * 512 + tid; idx < 128 * 64; idx += gridDim.x * 512) {
        const int i = idx >> 6, row = NP + i, c = (idx & 63) * 8;
        float z[8], bg[8], z1[8], z2[8], y[8], u[8], v[8];
        unpack8(*(const uint4*)(pZ + (size_t)row * 512 + c), z); unpack8(*(const uint4*)(pBG + (size_t)row * 512 + c), bg);
        unpack8(*(const uint4*)(pU + (size_t)row * 512 + c), u); unpack8(*(const uint4*)(pV + (size_t)row * 512 + c), v);
        const float* sp = p.state_conv + (size_t)i * 1024 + c;
#pragma unroll
        for (int j = 0; j < 8; ++j) { z2[j] = sp[j]; z1[j] = sp[512 + j]; }
        float* oc = p.out + O_CONVS + (size_t)i * 1024 + c;
        *(f32x4*)oc = (f32x4){z1[0], z1[1], z1[2], z1[3]}; *(f32x4*)(oc + 4) = (f32x4){z1[4], z1[5], z1[6], z1[7]};
        const int h = c >> 6; const float w00 = p.w_s[(size_t)h * 128 * 128], b0 = p.b_s[h * 128];
        uint4 o; o.x = cvt_pk_bf16(u[0] * (w00 * v[0] + b0), u[1] * (w00 * v[1] + b0)); o.y = cvt_pk_bf16(u[2] * (w00 * v[2] + b0), u[3] * (w00 * v[3] + b0));
        o.z = cvt_pk_bf16(u[4] * (w00 * v[4] + b0), u[5] * (w00 * v[5] + b0)); o.w = cvt_pk_bf16(u[6] * (w00 * v[6] + b0), u[7] * (w00 * v[7] + b0));
        *(uint4*)(mA + (size_t)row * DM + c) = o;
#pragma unroll
        for (int j = 0; j < 8; ++j) y[j] = bg[j] * (p.w_conv[c + j] * z2[j] + p.w_conv[512 + c + j] * z1[j] + p.w_conv[1024 + c + j] * z[j]);
        o.x = cvt_pk_bf16(y[0], y[1]); o.y = cvt_pk_bf16(y[2], y[3]); o.z = cvt_pk_bf16(y[4], y[5]); o.w = cvt_pk_bf16(y[6], y[7]);
        *(uint4*)(mA + (size_t)row * DM + 512 + c) = o;
    }
}

__global__ __launch_bounds__(512, 2) void fwd_megakernel(Params p) {
    extern __shared__ __attribute__((aligned(16))) unsigned char shm[];
    __shared__ uint4 xb_words;
    cg::grid_group grid = cg::this_grid();
    LAS unsigned char* lds = (LAS unsigned char*)shm;
    const int tid = fresh_tid(), G = gridDim.x, bid = blockIdx.x;
    if (tid == 0) xb_words = make_uint4(0u, 0u, 0u, 0u);
    __syncthreads();
    const XcdBarrier xb = xcd_barrier_post((unsigned*)(p.ws + WS_BAR), (volatile LAS unsigned*)&xb_words);
    bf16_t* WinT = (bf16_t*)(p.ws + WS_WIN); bf16_t* WoutT = (bf16_t*)(p.ws + WS_WOUT); bf16_t* Wff1T = (bf16_t*)(p.ws + WS_WFF1); bf16_t* Wff2T = (bf16_t*)(p.ws + WS_WFF2);
    bf16_t* WadaT = (bf16_t*)(p.ws + WS_WADA); bf16_t* Sb = (bf16_t*)(p.ws + WS_S);
    bf16_t* H = (bf16_t*)(p.ws + WS_H); bf16_t* mA = (bf16_t*)(p.ws + WS_MA); bf16_t* T = (bf16_t*)(p.ws + WS_R);
    float* mod = (float*)(p.ws + WS_MOD);
    { unsigned* cs = (unsigned*)(p.ws + WS_CNT) + CNT_S * 64;
      for (int i = bid * 512 + tid; i < 144 * DM / 8; i += G * 512) { const int b = i >> 7, k = (i & 127) * 8; uint4 o = {0u, 0u, 0u, 0u};
          if (b < NB) { const float* cp = (b < 8 ? p.c_prompt + (size_t)b * DM : p.c_sample + (size_t)(b - 8) * DM) + k; const f32x4 c0 = *(const f32x4*)cp, c1 = *(const f32x4*)(cp + 4);
              o.x = cvt_pk_bf16(silu_f(c0[0]), silu_f(c0[1])); o.y = cvt_pk_bf16(silu_f(c0[2]), silu_f(c0[3])); o.z = cvt_pk_bf16(silu_f(c1[0]), silu_f(c1[1])); o.w = cvt_pk_bf16(silu_f(c1[2]), silu_f(c1[3])); }
          *(uint4*)(Sb + (size_t)b * DM + k) = o; }
      if (bid < 144 * DM / 8 / 512) { asm volatile("s_waitcnt vmcnt(0)" ::: "memory"); __syncthreads();
          if (fresh_tid() == 0) { __builtin_amdgcn_fence(__ATOMIC_RELEASE, "agent"); asm volatile("s_waitcnt vmcnt(0)" ::: "memory"); xb_add(cs, 1u); } }
      bf16_t* Wt = (bf16_t*)(p.ws + WS_WTRIL);
      for (int i = bid * 512 + tid; i < 8 * 128 * 128; i += G * 512) { const int t = (i >> 7) & 127, s = i & 127; Wt[i] = (bf16_t)(cvt_pk_bf16(s <= t ? p.w_s[i] : 0.f, 0.f) & 0xffffu); }
      { int ctr = 0;
        transpose_cvt<true, true>(p.w_in, WinT, DM, DIN, (float*)shm, ctr, bid, G);
        transpose_cvt<false, true>(p.w_out, WoutT, DM, DM, (float*)shm, ctr, bid, G);
        transpose_cvt<false, true>(p.w_ff2, Wff2T, DFF, DM, (float*)shm, ctr, bid, G);
        transpose_cvt<false, true>(p.w_ff1, Wff1T, DM, DFF, (float*)shm, ctr, bid, G); }
      if (p.use_cg_sync) grid.sync();
      asm volatile("s_waitcnt vmcnt(0)" ::: "memory"); __syncthreads();
      if (fresh_tid() == 0) { asm volatile("buffer_inv sc1" ::: "memory"); spin_until(cs, 144 * DM / 8 / 512); asm volatile("s_waitcnt vmcnt(0)" ::: "memory"); }
      __syncthreads();
      mod_phase(p, Sb, (float*)shm); }
    xcd_barrier(xb);
    for (int rep = 0; rep < ((DUP >> 2) & 1) + 1; ++rep) {
    p1_prompt_rows(p);
    rownorm_phase<false>(p, p.g_mix, 0, 1024, false, NP, NTOK);
    }
    xcd_barrier(xb);
    { StaticOrder S; S.init(NP, DIN, G, bid, WGM_G1); Gemm g{H, WinT, NP, DIN, DM};
      EpiIn E{(bf16_t*)(p.ws + WS_PU), (bf16_t*)(p.ws + WS_PV), (bf16_t*)(p.ws + WS_PBG), (bf16_t*)(p.ws + WS_PZ), p.g_v, p.out};
      gemm_phase(lds, g, S, E);
      if (DUP & 8) gemm_phase(lds, g, S, E);
      small_gemm(H + (size_t)NP * DM, 8, WinT, DIN, DM, E, NP, (float*)shm, G == 256 ? bid - 128 : bid, G == 256 ? 128 : G);
      { const int blk = G == 256 ? bid - 128 : bid, nblk = G == 256 ? 128 : G;
        if (blk >= 0) { int ctr = 0;

 } } }
    xcd_barrier(xb);
    for (int rep = 0; rep < ((DUP >> 4) & 1) + 1; ++rep) {
    mixer_phase(p, shm);
    }
    xcd_barrier(xb);
    { StaticOrder S; S.init(NP, DM, G, bid); Gemm g{mA, WoutT, NP, DM, DM};
      EpiRes E{p.x_prompt, p.x_sample, mod, p.out, 2048, 0};
#if FUSE4
      EpiFused<0> EF{p.x_prompt, mod, p.g_ffn, p.out, H, (float*)(p.ws + WS_SLOT), (unsigned*)(p.ws + WS_CNT) + CNT_P4 * 64, (bf16_t*)(p.ws + WS_X1B)};
      gemm_phase(lds, g, S, EF, (float*)shm);
#else
      gemm_phase(lds, g, S, E);
#endif
      small_gemm_w<4, 8>(mA + (size_t)NP * DM, 8, WoutT, DM, DM, E, NP, (float*)shm); }
    xcd_barrier(xb);
#if !FUSE4
    rownorm_phase<false>(p, p.g_ffn, 3072, 4096, true);
    xcd_barrier(xb);
#endif
    { unsigned* ready6 = (unsigned*)(p.ws + WS_CNT) + CNT_READY6 * 64;
#if FUSE4
      if (bid < 16) {
          rownorm_phase<false, true>(p, p.g_ffn, 3072, 4096, true, NP, NTOK, 16);
          asm volatile("s_waitcnt vmcnt(0)" ::: "memory"); __syncthreads();
          if (fresh_tid() == 0) xb_add(ready6, 1u); }
#endif
      StaticOrder S; S.init(NP, DFF, G, bid, WGM_G3); Gemm g{H, Wff1T, NP, DFF, DM};
      EpiRelu2 E{T};
      gemm_phase(lds, g, S, E);
#if FUSE4
      if (fresh_tid() == 0) { spin_until(ready6, 16u); __builtin_amdgcn_fence(__ATOMIC_ACQUIRE, "agent"); asm volatile("s_waitcnt vmcnt(0)" ::: "memory"); }
      __syncthreads();
#endif
      small_gemm_w<1, 16, true>(H + (size_t)NP * DM, 8, Wff1T, DFF, DM, E, NP, (float*)shm); }
    xcd_barrier(xb);
    { unsigned* done7 = (unsigned*)(p.ws + WS_CNT) + CNT_DONE7 * 64;
      StaticOrder S; S.init(NP, DM, G, bid); Gemm g{T, Wff2T, NP, DM, DFF};
      EpiRes E{p.x_prompt, p.x_sample, mod, p.out, 5120, 1};
#if FUSE7
      small_gemm_w<4, 16>(T + (size_t)NP * DFF, 8, Wff2T, DM, DFF, E, NP, (float*)shm);
      asm volatile("s_waitcnt vmcnt(0)" ::: "memory"); __syncthreads();
      if (fresh_tid() == 0) xb_add(done7, 1u);
      EpiFused<1> EF{p.x_prompt, mod, p.g_final, p.out, H, (float*)(p.ws + WS_SLOT) + 64 * 4 * 256, (unsigned*)(p.ws + WS_CNT) + CNT_P7 * 64, (bf16_t*)(p.ws + WS_X1B)};
      gemm_phase(lds, g, S, EF, (float*)shm);
      if (bid < 16) {
          if (fresh_tid() == 0) { spin_until(done7, (unsigned)G); __builtin_amdgcn_fence(__ATOMIC_ACQUIRE, "agent"); asm volatile("s_waitcnt vmcnt(0)" ::: "memory"); }
          __syncthreads();
          rownorm_phase<true>(p, p.g_final, 0, 0, true, NP, NTOK, 16); }
#else
      gemm_phase(lds, g, S, E);
      small_gemm_w<4, 16>(T + (size_t)NP * DFF, 8, Wff2T, DM, DFF, E, NP, (float*)shm);
#endif
    }
#if !FUSE7
    xcd_barrier(xb);
    rownorm_phase<true>(p, p.g_final, 0, 0, true);
#endif
}

extern "C" void kernel_launch(void* const* d_in, const int* in_sizes, int n_in, void* d_out, int out_size, void* d_ws, size_t ws_size, hipStream_t stream) {
    static int grid = 0;
    if (grid == 0) {
        if (n_in != 18 || in_sizes[0] != NP * DM || (size_t)out_size != O_END || ws_size < WS_END) {
            fprintf(stderr, "kernel_launch: unexpected shapes (n_in %d, in0 %d, out %d, ws %zu, need %zu)\n", n_in, n_in > 0 ? in_sizes[0] : -1, out_size, ws_size, (size_t)WS_END); grid = -1; return; }
        int dev = 0, cus = 0, per_cu = 0;
        (void)hipGetDevice(&dev); (void)hipDeviceGetAttribute(&cus, hipDeviceAttributeMultiprocessorCount, dev);
        if (hipFuncSetAttribute((const void*)fwd_megakernel, hipFuncAttributeMaxDynamicSharedMemorySize, LDS_BYTES) != hipSuccess) { fprintf(stderr, "kernel_launch: hipFuncSetAttribute failed\n"); grid = -1; return; }
        if (hipOccupancyMaxActiveBlocksPerMultiprocessor(&per_cu, (const void*)fwd_megakernel, 512, LDS_BYTES) != hipSuccess || per_cu < 1) { fprintf(stderr, "kernel_launch: occupancy query failed (%d)\n", per_cu); grid = -1; return; }
        grid = cus * per_cu;
        if (grid != 256) { fprintf(stderr, "kernel_launch: built for 256 co-resident workgroups, got %d\n", grid); grid = -1; return; }
    }
    if (grid < 0) return;
    Params p{};
    p.x_prompt = (const float*)d_in[0]; p.x_sample = (const float*)d_in[1]; p.c_prompt = (const float*)d_in[2]; p.c_sample = (const float*)d_in[3]; p.state_conv = (const float*)d_in[4];
    p.g_mix = (const float*)d_in[5]; p.w_ada = (const float*)d_in[6]; p.b_ada = (const float*)d_in[7]; p.w_in = (const float*)d_in[8]; p.g_v = (const float*)d_in[9];
    p.w_s = (const float*)d_in[10]; p.b_s = (const float*)d_in[11]; p.w_conv = (const float*)d_in[12]; p.w_out = (const float*)d_in[13]; p.g_ffn = (const float*)d_in[14];
    p.w_ff1 = (const float*)d_in[15]; p.w_ff2 = (const float*)d_in[16]; p.g_final = (const float*)d_in[17];
    p.out = (float*)d_out; p.ws = (unsigned char*)d_ws;
    if (hipMemsetAsync((char*)d_ws + WS_BAR, 0, 16384 + CNT_BYTES, stream) != hipSuccess) { fprintf(stderr, "kernel_launch: memset failed\n"); return; }
    void* args[] = {&p};
    hipError_t e = hipLaunchCooperativeKernel((const void*)fwd_megakernel, dim3(grid), dim3(512), args, LDS_BYTES, stream);
    if (e != hipSuccess) fprintf(stderr, "cooperative launch failed: %s (grid %d)\n", hipGetErrorString(e), grid);
}
```

```cpp
#include <hip/hip_runtime.h>
#include <hip/hip_cooperative_groups.h>
#include <cstdio>
namespace cg = cooperative_groups;

#define LAS __attribute__((address_space(3)))
typedef unsigned short bf16_t;
typedef short bf16x8 __attribute__((ext_vector_type(8)));
typedef float f32x4 __attribute__((ext_vector_type(4)));

constexpr int DM = 1024, NP = 16384, NTOK = 16512, MPAD = 16640, NB = 136, NMOD = 6144, DIN = 2560, DFF = 4096;
constexpr int BM = 256, BK = 64, HALF = 128, HTB = HALF * BK * 2, STAGE_BYTES = 8 * HTB, NXCD = 8, WGM = 4;
constexpr int LDS_BYTES = STAGE_BYTES;
constexpr float EPS = 1e-6f;
#define WGM_G1 8
#define WGM_G3 4
#define DUP 0

constexpr size_t WS_WIN = 0;
constexpr size_t WS_WOUT = WS_WIN + (size_t)DIN * DM * 2;
constexpr size_t WS_WFF1 = WS_WOUT + (size_t)DM * DM * 2;
constexpr size_t WS_WFF2 = WS_WFF1 + (size_t)DFF * DM * 2;
constexpr size_t WS_WTRIL = WS_WFF2 + (size_t)DM * DFF * 2;
constexpr size_t WS_MOD = WS_WTRIL + (size_t)8 * 128 * 128 * 2;
constexpr size_t WS_H = WS_MOD + (size_t)NB * NMOD * 4;
constexpr size_t WS_R = WS_H + (size_t)MPAD * DM * 2;
constexpr size_t WS_PU = WS_R;
constexpr size_t WS_PV = WS_PU + (size_t)MPAD * 512 * 2;
constexpr size_t WS_PBG = WS_PV + (size_t)MPAD * 512 * 2;
constexpr size_t WS_PZ = WS_PBG + (size_t)MPAD * 512 * 2;
constexpr size_t WS_MA = WS_PZ + (size_t)MPAD * 512 * 2;
constexpr size_t WS_WADA = WS_R + (size_t)MPAD * DFF * 2;
constexpr size_t WS_S = WS_WADA + (size_t)NMOD * DM * 2;
constexpr size_t WS_BAR = WS_S + (size_t)144 * DM * 2;
constexpr size_t WS_CNT = WS_BAR + 16384;
constexpr int CNT_BYTES = 36864, CNT_P4 = 0, CNT_P7 = 64, CNT_READY6 = 128, CNT_DONE7 = 129, CNT_S = 130;
constexpr size_t WS_SLOT = WS_CNT + CNT_BYTES;
constexpr size_t WS_X1B = WS_SLOT + (size_t)2 * 64 * 4 * 256 * 4;
constexpr size_t WS_END = WS_X1B + (size_t)NP * DM * 2;
#define FUSE4 1
#define FUSE7 1
constexpr size_t O_Y = 0, O_CONVP = (size_t)NTOK * DM, O_CONVS = O_CONVP + 8 * 2 * 512, O_VS = O_CONVS + 128 * 2 * 512, O_END = O_VS + 128 * 512;

struct Params {
    const float *x_prompt, *x_sample, *c_prompt, *c_sample, *state_conv, *g_mix, *w_ada, *b_ada, *w_in, *g_v, *w_s, *b_s, *w_conv, *w_out, *g_ffn, *w_ff1, *w_ff2, *g_final;
    float* out; unsigned char* ws; int use_cg_sync; int pad0;
};

__device__ __forceinline__ unsigned cvt_pk_bf16(float lo, float hi) { unsigned r; asm("v_cvt_pk_bf16_f32 %0, %1, %2" : "=v"(r) : "v"(lo), "v"(hi)); return r; }
__device__ __forceinline__ float bf_lo(unsigned u) { return __uint_as_float(u << 16); }
__device__ __forceinline__ float bf_hi(unsigned u) { return __uint_as_float(u & 0xffff0000u); }
__device__ __forceinline__ float gelu_tanh(float x) { const float u = 1.5957691216f * (x + 0.044715f * x * x * x); return x * __builtin_amdgcn_rcpf(1.f + __expf(-u)); }
__device__ __forceinline__ float silu_f(float x) { return x * __builtin_amdgcn_rcpf(1.f + __expf(-x)); }
__device__ __forceinline__ void st_bf16x4(bf16_t* p, f32x4 v) { uint2 o; o.x = cvt_pk_bf16(v[0], v[1]); o.y = cvt_pk_bf16(v[2], v[3]); *(uint2*)p = o; }
__device__ __forceinline__ int batch_of(int row) { return row < NP ? (row >> 11) : (row < NTOK ? 8 + row - NP : NB - 1); }
union Frag { bf16x8 v; unsigned u[4]; uint4 q; };
__device__ __forceinline__ void unpack8(const uint4 q, float (&f)[8]) { f[0] = bf_lo(q.x); f[1] = bf_hi(q.x); f[2] = bf_lo(q.y); f[3] = bf_hi(q.y); f[4] = bf_lo(q.z); f[5] = bf_hi(q.z); f[6] = bf_lo(q.w); f[7] = bf_hi(q.w); }
__device__ __forceinline__ int fresh_tid() { int t = threadIdx.x; asm volatile("" : "+v"(t)); return t; }


#define XB_TMO      128
#define XB_XCNT(j)  (256  + 64 * (j))
#define XB_XSUB(j)  (1280 + 64 * (j))
#define XB_XGEN(j)  (2304 + 64 * (j))
#define XB_TOP      3328
#define XB_TOPGEN   3392
#define XCD_BAR_WORDS 3456
#define XB_SPIN_CAP (1u << 18)
__device__ __forceinline__ unsigned xb_ld(unsigned* p)              { return __hip_atomic_load(p, __ATOMIC_RELAXED, __HIP_MEMORY_SCOPE_AGENT); }
__device__ __forceinline__ unsigned xb_add(unsigned* p, unsigned v) { return __hip_atomic_fetch_add(p, v, __ATOMIC_RELAXED, __HIP_MEMORY_SCOPE_AGENT); }
__device__ __forceinline__ unsigned xb_xcc_id() { return (unsigned)__builtin_amdgcn_s_getreg((3 << 11) | 20) & 0xFu; }
#define XB_SPIN(cond, bar) do { unsigned _sp = 0; while (cond) { __builtin_amdgcn_s_sleep(1); \
    if ((++_sp & 255u) == 0u) { if (xb_ld(&(bar)[XB_TMO])) break; if (_sp > XB_SPIN_CAP) { atomicAdd(&(bar)[XB_TMO], 1u); break; } } } } while (0)
struct XcdBarrier { unsigned* bar; unsigned x; volatile LAS unsigned* st; };
__device__ __forceinline__ XcdBarrier xcd_barrier_post(unsigned* bar, volatile LAS unsigned* st) {
    XcdBarrier b; b.bar = bar; b.x = xb_xcc_id(); b.st = st;
    if (threadIdx.x == 0) (void)xb_add(&bar[XB_XCNT(b.x)], 1u);
    return b;
}
__device__ __forceinline__ void xcd_barrier_complete(unsigned* bar, unsigned x, unsigned& nloc, unsigned& nx) {
    const unsigned G = gridDim.x * gridDim.y * gridDim.z;
    unsigned sum, cnt, mine, sp = 0u;
    for (;;) {
        sum = 0u; cnt = 0u; mine = 0u;
#pragma unroll
        for (unsigned j = 0; j < 16; ++j) { const unsigned c = xb_ld(&bar[XB_XCNT(j)]); sum += c; cnt += (c > 0u) ? 1u : 0u; mine = (j == x) ? c : mine; }
        if (sum == G) break;
        __builtin_amdgcn_s_sleep(1);
        if ((++sp & 255u) == 0u) { if (xb_ld(&bar[XB_TMO])) break; if (sp > XB_SPIN_CAP) { atomicAdd(&bar[XB_TMO], 1u); break; } }
    }
    nloc = mine > 0u ? mine : 1u; nx = cnt > 0u ? cnt : 1u;
}
__device__ __forceinline__ void xcd_barrier(const XcdBarrier& b) {
    asm volatile("s_waitcnt vmcnt(0)" ::: "memory");
    __syncthreads();
    if (threadIdx.x == 0) {
        unsigned* bar = b.bar;
        __builtin_amdgcn_s_waitcnt(0);
        unsigned nloc = b.st[0], nx = b.st[1];
        if (nloc == 0u) { xcd_barrier_complete(bar, b.x, nloc, nx); b.st[0] = nloc; b.st[1] = nx; }
        const unsigned old = xb_add(&bar[XB_XSUB(b.x)], 1u);
        const unsigned gen = old / nloc;
        if (old + 1u == (gen + 1u) * nloc) {
            __builtin_amdgcn_fence(__ATOMIC_RELEASE, "agent");
            asm volatile("s_waitcnt vmcnt(0)" ::: "memory");
            const unsigned og = xb_add(&bar[XB_TOP], 1u);
            const unsigned tg = og / nx;
            asm volatile("buffer_inv sc1" ::: "memory");
            if (og + 1u == (tg + 1u) * nx) xb_add(&bar[XB_TOPGEN], 1u);
            else XB_SPIN(xb_ld(&bar[XB_TOPGEN]) == tg, bar);
            xb_add(&bar[XB_XGEN(b.x)], 1u);
            asm volatile("s_waitcnt vmcnt(0)" ::: "memory");
        } else {
            asm volatile("buffer_inv sc1" ::: "memory");
            XB_SPIN(xb_ld(&bar[XB_XGEN(b.x)]) == gen, bar);
            asm volatile("s_waitcnt vmcnt(0)" ::: "memory");
        }
    }
    __syncthreads();
}

__device__ __forceinline__ int lds_byte(int r, int c) { const int st = (r >> 4) * 2 + (c >> 5), rr = r & 15, cc = c & 31, ob = rr * 64 + cc * 2; return st * 1024 + (ob ^ (((ob >> 9) & 1) << 5)); }
__device__ __forceinline__ void stage_rc(int b, int& R, int& C) { const int st = b / 1024, sb = b % 1024, swz = sb ^ (((sb >> 9) & 1) << 5); R = (st >> 1) * 16 + swz / 64; C = (st & 1) * 32 + (swz % 64) / 2; }

__device__ __forceinline__ int perm32(int rho) { const int n = rho >> 4, i = rho & 15; return 8 * (i >> 2) + 4 * n + (i & 3); }
__device__ __forceinline__ void st_bf16x8(bf16_t* p, const f32x4 a, const f32x4 b) { uint4 o; o.x = cvt_pk_bf16(a[0], a[1]); o.y = cvt_pk_bf16(a[2], a[3]); o.z = cvt_pk_bf16(b[0], b[1]); o.w = cvt_pk_bf16(b[2], b[3]); *(uint4*)p = o; }
typedef unsigned u32x4w __attribute__((ext_vector_type(4)));
__device__ __forceinline__ void st_wt_f32x4(float* p, const f32x4 v) { asm volatile("global_store_dwordx4 %0, %1, off sc1\n\ts_nop 1" :: "v"(p), "v"(v) : "memory"); }
__device__ __forceinline__ void st_wt_bf16x8(bf16_t* p, const f32x4 a, const f32x4 b) { const u32x4w o = {cvt_pk_bf16(a[0], a[1]), cvt_pk_bf16(a[2], a[3]), cvt_pk_bf16(b[0], b[1]), cvt_pk_bf16(b[2], b[3])};
    asm volatile("global_store_dwordx4 %0, %1, off sc1\n\ts_nop 1" :: "v"(p), "v"(o) : "memory"); }
struct Unit { int pm, pn; };
struct Gemm { const bf16_t* A; const bf16_t* Bt; int M, N, K; };
struct StaticOrder {
    int nM, nN, nwg, G, c, wgm;
    __device__ void init(int M, int N, int G_, int c_, int wgm_ = WGM) { nM = M / BM; nN = N / BM; nwg = nM * nN; G = G_; c = c_; wgm = wgm_; }
    __device__ bool next(int i, Unit& u) const {
        const long L = (long)i * G + c; if (L >= nwg) return false;
        int wgid = (int)L; { const int q = nwg / NXCD, r = nwg % NXCD, xcd = wgid % NXCD, off = wgid / NXCD; wgid = (xcd < r ? xcd * (q + 1) : r * (q + 1) + (xcd - r) * q) + off; }
        const int nig = wgm * nN, gid = wgid / nig, fm = gid * wgm, gsz = (nM - fm) < wgm ? (nM - fm) : wgm;
        u.pm = fm + ((wgid % nig) % gsz); u.pn = (wgid % nig) / gsz; return true;
    }
};

#define EPI_MAIN_CALL \
    static constexpr bool AFTER_DRAIN = false; \
    __device__ __forceinline__ void operator()(const f32x4 (&acc)[2][2][4][2], const Unit& u, int wr, int wc, int fr, int fq) const { \
        const int rowb = u.pm * BM + wr * 64 + fr; \
        _Pragma("unroll") for (int ai = 0; ai < 2; ++ai) _Pragma("unroll") for (int m = 0; m < 4; ++m) { \
            const f32x4 a[2][2] = {{acc[ai][0][m][0], acc[ai][0][m][1]}, {acc[ai][1][m][0], acc[ai][1][m][1]}}; \
            row(a, rowb + ai * HALF + m * 16, u.pn, wc, fq); } }
struct EpiIn {
    bf16_t *pU, *pV, *pBG, *pZ; const float* g_v; float* out;
    __device__ __forceinline__ void row(const f32x4 (&a)[2][2], int row, int pn, int wc, int fq) const {
        if (pn < 2 || pn == 4 || pn == 5) {
            bf16_t* dst = (pn < 2 ? pU : pBG) + (size_t)row * 512 + (pn & 1) * 256 + wc * 32 + 8 * fq;
#pragma unroll
            for (int bj = 0; bj < 2; ++bj) { f32x4 v0 = a[bj][0], v1 = a[bj][1];
                if (pn < 2) {
#pragma unroll
                    for (int j = 0; j < 4; ++j) { v0[j] = gelu_tanh(v0[j]); v1[j] = gelu_tanh(v1[j]); } }
                st_bf16x8(dst + bj * HALF, v0, v1); }
        } else if (pn < 4) {
            const int head = (pn - 2) * 4 + wc;
            f32x4 g[2][2]; float ss = 0.f;
#pragma unroll
            for (int bj = 0; bj < 2; ++bj)
#pragma unroll
                for (int n = 0; n < 2; ++n)
#pragma unroll
                    for (int j = 0; j < 4; ++j) { const float t = gelu_tanh(a[bj][n][j]); g[bj][n][j] = t; ss += t * t; }
            ss += __shfl_xor(ss, 16); ss += __shfl_xor(ss, 32);
            const float rs = rsqrtf(ss * (1.f / 64.f) + EPS);
#pragma unroll
            for (int bj = 0; bj < 2; ++bj) { const int d = head * 64 + bj * 32 + 8 * fq;
                const f32x4 v0 = g[bj][0] * rs * *(const f32x4*)(g_v + d), v1 = g[bj][1] * rs * *(const f32x4*)(g_v + d + 4);
                st_bf16x8(pV + (size_t)row * 512 + d, v0, v1);
                if (row >= NP && row < NTOK) { float* o = out + O_VS + (size_t)(row - NP) * 512 + d; *(f32x4*)o = v0; *(f32x4*)(o + 4) = v1; } }
        } else {
            const int c = (pn - 6) * 128 + wc * 32 + 8 * fq;
            const f32x4 z0 = a[0][0] * a[1][0], z1 = a[0][1] * a[1][1];
            st_bf16x8(pZ + (size_t)row * 512 + c, z0, z1);
            float* o = nullptr;
            if (row < NP) { const int t = row & 2047; if (t >= 2046) o = out + O_CONVP + (size_t)((row >> 11) * 2 + (t - 2046)) * 512 + c; }
            else if (row < NTOK) o = out + O_CONVS + (size_t)((row - NP) * 2 + 1) * 512 + c;
            if (o) { *(f32x4*)o = z0; *(f32x4*)(o + 4) = z1; }
        }
    }
    EPI_MAIN_CALL
};
struct EpiRes {
    const float *xp, *xs, *mod; float* out; int gate_off; int inplace;
    __device__ __forceinline__ void row(const f32x4 (&a)[2][2], int row, int pn, int wc, int fq) const {
        if (row < NTOK) { const int cb = pn * BM + wc * 32 + 4 * fq;
            const float* gt = mod + (size_t)batch_of(row) * NMOD + gate_off; float* orow = out + (size_t)row * DM;
            const float* br = inplace ? orow : (row < NP ? xp + (size_t)row * DM : xs + (size_t)(row - NP) * DM);
#pragma unroll
            for (int bj = 0; bj < 2; ++bj)
#pragma unroll
                for (int n = 0; n < 2; ++n) { const int c = cb + bj * HALF + n * 16;
                    *(f32x4*)(orow + c) = *(const f32x4*)(br + c) + *(const f32x4*)(gt + c) * a[bj][n]; } }
    }
    __device__ __forceinline__ void frag(const f32x4 a, int row, int cs) const {
        const int c = (cs & ~31) + perm32(cs & 31);
        const float* gt = mod + (size_t)batch_of(row) * NMOD + gate_off; float* orow = out + (size_t)row * DM;
        const float* br = inplace ? orow : (row < NP ? xp + (size_t)row * DM : xs + (size_t)(row - NP) * DM);
        const f32x4 r = *(const f32x4*)(br + c) + *(const f32x4*)(gt + c) * a;
        if (inplace) st_wt_f32x4(orow + c, r); else *(f32x4*)(orow + c) = r; }
    EPI_MAIN_CALL
};
struct EpiRelu2 {
    bf16_t* T;
    __device__ __forceinline__ void row(const f32x4 (&a)[2][2], int row, int pn, int wc, int fq) const {
        bf16_t* rp = T + (size_t)row * DFF + pn * BM + wc * 32 + 8 * fq;
#pragma unroll
        for (int bj = 0; bj < 2; ++bj) { f32x4 v0 = a[bj][0], v1 = a[bj][1];
#pragma unroll
            for (int j = 0; j < 4; ++j) { const float r0 = fmaxf(v0[j], 0.f), r1 = fmaxf(v1[j], 0.f); v0[j] = r0 * r0; v1[j] = r1 * r1; }
            st_bf16x8(rp + bj * HALF, v0, v1); }
    }
    __device__ __forceinline__ void frag(f32x4 v, int row, int c) const {
#pragma unroll
        for (int j = 0; j < 4; ++j) { const float r = fmaxf(v[j], 0.f); v[j] = r * r; }
        st_bf16x4(T + (size_t)row * DFF + (c & ~31) + perm32(c & 31), v); }
    EPI_MAIN_CALL
};
struct EpiNull {
    float* sink; int flag;
    __device__ __forceinline__ void row(const f32x4 (&a)[2][2], int row, int pn, int wc, int fq) const {
        if (flag) { *(f32x4*)(sink + (size_t)row * DM + pn * BM + wc * 32 + 4 * fq) = a[0][0] + a[0][1] + a[1][0] + a[1][1]; } }
    EPI_MAIN_CALL
};
__device__ __forceinline__ void spin_until(unsigned* p, unsigned need) { unsigned sp = 0; while (xb_ld(p) < need) { __builtin_amdgcn_s_sleep(1); if (++sp > (1u << 20)) break; } }
template <int MODE>
struct EpiFused {
    static constexpr bool AFTER_DRAIN = true;
    const float *xp, *mod, *g; float* out; bf16_t* H; float* slots; unsigned* cnt; bf16_t* X1;
    __device__ __forceinline__ void fused(f32x4 (&acc)[2][2][4][2], const Unit& u, int wr, int wc, int fr, int fq, float* smem) const {
        const int tid = fresh_tid();
        const float* mb = mod + (size_t)(u.pm >> 3) * NMOD;
        const int cb = u.pn * BM + wc * 32 + 8 * fq, rl0 = wr * 64 + fr;
        float* part = smem; float* rsv = smem + 1024;
        f32x4 gt[2][2];
#pragma unroll
        for (int bj = 0; bj < 2; ++bj)
#pragma unroll
            for (int n = 0; n < 2; ++n) gt[bj][n] = *(const f32x4*)(mb + (MODE ? 5120 : 2048) + cb + bj * HALF + n * 4);
#pragma unroll
        for (int ai = 0; ai < 2; ++ai) {
            f32x4 bs[4][2][2];
#pragma unroll
            for (int m = 0; m < 4; ++m) { const size_t ro = (size_t)(u.pm * BM + rl0 + ai * HALF + m * 16) * DM;
#pragma unroll
                for (int bj = 0; bj < 2; ++bj)
#pragma unroll
                    for (int n = 0; n < 2; ++n) { const int c = cb + bj * HALF + n * 4;
                        if (MODE) { const uint2 q = *(const uint2*)(X1 + ro + c); bs[m][bj][n] = (f32x4){bf_lo(q.x), bf_hi(q.x), bf_lo(q.y), bf_hi(q.y)}; }
                        else bs[m][bj][n] = *(const f32x4*)(xp + ro + c); } }
            __builtin_amdgcn_sched_barrier(0);
#pragma unroll
            for (int m = 0; m < 4; ++m) { float ss = 0.f;
#pragma unroll
                for (int bj = 0; bj < 2; ++bj)
#pragma unroll
                    for (int n = 0; n < 2; ++n) { const f32x4 v = bs[m][bj][n] + gt[bj][n] * acc[ai][bj][m][n]; acc[ai][bj][m][n] = v; ss += v[0] * v[0] + v[1] * v[1] + v[2] * v[2] + v[3] * v[3]; }
                ss += __shfl_xor(ss, 16); ss += __shfl_xor(ss, 32);
                if (fq == 0) part[(rl0 + ai * HALF + m * 16) * 4 + wc] = ss; } }
        __syncthreads();
        if (tid < 256) { const f32x4 q = *(const f32x4*)(part + tid * 4); __hip_atomic_store(slots + (size_t)(u.pm * 4 + u.pn) * 256 + tid, (q[0] + q[1]) + (q[2] + q[3]), __ATOMIC_RELAXED, __HIP_MEMORY_SCOPE_AGENT); }
        asm volatile("s_waitcnt vmcnt(0)" ::: "memory");
        __syncthreads();
        if (tid == 0) { xb_add(cnt + u.pm * 64, 1u); spin_until(cnt + u.pm * 64, 4u); }
        f32x4 gs[2][2], sh[2][2];
#pragma unroll
        for (int bj = 0; bj < 2; ++bj)
#pragma unroll
            for (int n = 0; n < 2; ++n) { const int c = cb + bj * HALF + n * 4; gs[bj][n] = *(const f32x4*)(g + c);
                if (MODE == 0) { gs[bj][n] = gs[bj][n] * (*(const f32x4*)(mb + 4096 + c) + 1.f); sh[bj][n] = *(const f32x4*)(mb + 3072 + c); } }
        __syncthreads();
        if (tid < 256) { float s = 0.f;
#pragma unroll
            for (int q = 0; q < 4; ++q) s += __hip_atomic_load(slots + (size_t)(u.pm * 4 + q) * 256 + tid, __ATOMIC_RELAXED, __HIP_MEMORY_SCOPE_AGENT);
            rsv[tid] = rsqrtf(s * (1.f / DM) + EPS); }
        __syncthreads();
#pragma unroll
        for (int ai = 0; ai < 2; ++ai)
#pragma unroll
            for (int m = 0; m < 4; ++m) { const int rl = rl0 + ai * HALF + m * 16; const size_t ro = (size_t)(u.pm * BM + rl) * DM; const float r = rsv[rl];
#pragma unroll
                for (int bj = 0; bj < 2; ++bj) { const int c = cb + bj * HALF; const f32x4 v0 = acc[ai][bj][m][0], v1 = acc[ai][bj][m][1];
                    if (MODE == 0) { st_bf16x8(X1 + ro + c, v0, v1); st_bf16x8(H + ro + c, v0 * r * gs[bj][0] + sh[bj][0], v1 * r * gs[bj][1] + sh[bj][1]); }
                    else { *(f32x4*)(out + ro + c) = v0 * r * gs[bj][0]; *(f32x4*)(out + ro + c + 4) = v1 * r * gs[bj][1]; } } }
        __syncthreads();
    }
};
struct EpiMod {
    float* mod; const float* b_ada;
    __device__ __forceinline__ void frag(const f32x4 a, int row, int c) const { if (row < NB) *(f32x4*)(mod + (size_t)row * NMOD + c) = a + *(const f32x4*)(b_ada + c); }
    __device__ __forceinline__ void row(const f32x4 (&a)[2][2], int row, int pn, int wc, int fq) const {
        if (row < NB) { const int cb = pn * BM + wc * 32 + 4 * fq;
#pragma unroll
            for (int bj = 0; bj < 2; ++bj)
#pragma unroll
                for (int n = 0; n < 2; ++n) { const int c = cb + bj * HALF + n * 16; *(f32x4*)(mod + (size_t)row * NMOD + c) = a[bj][n] + *(const f32x4*)(b_ada + c); } }
    }
};

template <class Epi>
__device__ __forceinline__ void small_gemm(const bf16_t* __restrict__ A, int nm16, const bf16_t* __restrict__ Bt, int N, int K, const Epi& E, int row_base, float* smem, int blk, int nblk) {
    if (blk < 0) return;
    const int tid = fresh_tid(), w = tid >> 6, lane = tid & 63, fr = lane & 15, fq = lane >> 4;
    const int ntasks = (N / 256) * 4 * nm16, kw = K / 8;
    f32x4* red = (f32x4*)smem;
    for (int t = blk; t < ntasks; t += nblk) {
        const int m16 = t % nm16, r = t / nm16, wc = r & 3, pn = r >> 2;
        const bf16_t* ap = A + (size_t)(m16 * 16 + fr) * K + w * kw + fq * 8;
        const bf16_t* bp = Bt + (size_t)(pn * 256 + wc * 32 + fr) * K + w * kw + fq * 8;
        f32x4 acc[2][2] = {{{0.f, 0.f, 0.f, 0.f}, {0.f, 0.f, 0.f, 0.f}}, {{0.f, 0.f, 0.f, 0.f}, {0.f, 0.f, 0.f, 0.f}}};
#pragma unroll 4
        for (int ks = 0; ks < kw / 32; ++ks) {
            Frag a; a.q = *(const uint4*)(ap + ks * 32);
#pragma unroll
            for (int bj = 0; bj < 2; ++bj)
#pragma unroll
                for (int n = 0; n < 2; ++n) { Frag b; b.q = *(const uint4*)(bp + (size_t)(bj * 128 + n * 16) * K + ks * 32);
                    acc[bj][n] = __builtin_amdgcn_mfma_f32_16x16x32_bf16(b.v, a.v, acc[bj][n], 0, 0, 0); }
        }
#pragma unroll
        for (int i = 0; i < 4; ++i) red[(w * 4 + i) * 64 + lane] = acc[i >> 1][i & 1];
        __syncthreads();
        if (w == 0) { f32x4 s[2][2];
#pragma unroll
            for (int i = 0; i < 4; ++i) { f32x4 v = red[i * 64 + lane];
#pragma unroll
                for (int w2 = 1; w2 < 8; ++w2) v += red[(w2 * 4 + i) * 64 + lane];
                s[i >> 1][i & 1] = v; }
            E.row(s, row_base + m16 * 16 + fr, pn, wc, fq); }
        __syncthreads();
    }
}


template <int KSPLIT, int BATCH, bool SHAREB = false, class Epi>
__device__ __forceinline__ void small_gemm_w(const bf16_t* __restrict__ A, int nm16, const bf16_t* __restrict__ Bt, int N, int K, const Epi& E, int row_base, float* smem) {
    const int tid = fresh_tid(), w = tid >> 6, lane = tid & 63, fr = lane & 15, fq = lane >> 4;
    const int total = nm16 * (N / 16) * KSPLIT, kw = K / KSPLIT;
    f32x4* red = (f32x4*)smem;
    for (int base = blockIdx.x * 8; base < total; base += gridDim.x * 8) {
        const int task = base + w; const bool valid = task < total;
        const int tile = task / KSPLIT, ks = task % KSPLIT, m16 = tile % nm16, n16 = tile / nm16;
        f32x4 acc = {0.f, 0.f, 0.f, 0.f};
        if (KSPLIT == 1 && SHAREB) {
            __syncthreads();
            uint4* Bs = (uint4*)smem; const int nst = kw / 32, per = nst / 8;
            const bf16_t* bpb = Bt + (size_t)((base / nm16) * 16 + fr) * K + fq * 8;
            for (int j = 0; j < per; ++j) { const int s = w * per + j; Bs[s * 64 + lane] = *(const uint4*)(bpb + s * 32); }
            __syncthreads();
            if (valid) {
                const bf16_t* ap = A + (size_t)(m16 * 16 + fr) * K + fq * 8;
                for (int s0 = 0; s0 < nst; s0 += BATCH) { Frag a[BATCH];
#pragma unroll
                    for (int i = 0; i < BATCH; ++i) a[i].q = *(const uint4*)(ap + (s0 + i) * 32);
                    __builtin_amdgcn_sched_barrier(0);
#pragma unroll
                    for (int i = 0; i < BATCH; ++i) { Frag b; b.q = Bs[(s0 + i) * 64 + lane]; acc = __builtin_amdgcn_mfma_f32_16x16x32_bf16(b.v, a[i].v, acc, 0, 0, 0); }
                    __builtin_amdgcn_sched_barrier(0); } }
            __syncthreads();
        } else if (valid) {
            const bf16_t* ap = A + (size_t)(m16 * 16 + fr) * K + ks * kw + fq * 8;
            const bf16_t* bp = Bt + (size_t)(n16 * 16 + fr) * K + ks * kw + fq * 8;
            for (int s0 = 0; s0 < kw / 32; s0 += BATCH) { Frag a[BATCH], b[BATCH];
#pragma unroll
                for (int i = 0; i < BATCH; ++i) { a[i].q = *(const uint4*)(ap + (s0 + i) * 32); b[i].q = *(const uint4*)(bp + (s0 + i) * 32); }
                __builtin_amdgcn_sched_barrier(0);
#pragma unroll
                for (int i = 0; i < BATCH; ++i) acc = __builtin_amdgcn_mfma_f32_16x16x32_bf16(b[i].v, a[i].v, acc, 0, 0, 0);
                __builtin_amdgcn_sched_barrier(0); }
        }
        if (KSPLIT > 1) {
            red[w * 64 + lane] = acc;
            __syncthreads();
            if (ks == 0) {
#pragma unroll
                for (int j = 1; j < KSPLIT; ++j) acc += red[(w + j) * 64 + lane]; }
        }
        if (valid && ks == 0) E.frag(acc, row_base + m16 * 16 + fr, n16 * 16 + 4 * fq);
        if (KSPLIT > 1) __syncthreads();
    }
}

template <class Epi>
__device__ __forceinline__ void gemm_phase(LAS unsigned char* lds, const Gemm g, const StaticOrder& S, const Epi& E, float* smem = nullptr) {
    const int tid = fresh_tid(), wid = __builtin_amdgcn_readfirstlane(tid >> 6), lane = tid & 63, wr = wid >> 2, wc = wid & 3, fr = lane & 15, fq = lane >> 4;
    const int K = g.K, nt = K / BK;
    unsigned voffA[2];
#pragma unroll
    for (int i = 0; i < 2; ++i) { int R, C; stage_rc(tid * 16 + i * 8192, R, C); voffA[i] = (unsigned)(R * K + C) * 2u; }
    const size_t kstep = (size_t)(BK * 2), hstep = (size_t)HALF * K * 2, tstep = 2 * hstep;
    const unsigned ldsw = (unsigned)wid * 1024u;
    const int aoff = lds_byte(wr * 64 + fr, fq * 8), boff = lds_byte(wc * 32 + fr, fq * 8);
#define PG8_SA(b, h) (((b) * 2 + (h)) * HTB)
#define PG8_SB(b, h) ((4 + (b) * 2 + (h)) * HTB)
#define PG8_STAGE(bufoff, gbase, voff) do { _Pragma("unroll") for (int _i = 0; _i < 2; ++_i) \
        __builtin_amdgcn_global_load_lds((const unsigned*)((const char*)(gbase) + (voff)[_i]), (LAS unsigned*)(lds + (bufoff) + ldsw + _i * 8192), 16, 0, 0); } while (0)
#define PG8_LDA(dst, b, h) do { _Pragma("unroll") for (int m = 0; m < 4; ++m) _Pragma("unroll") for (int k = 0; k < 2; ++k) dst[m][k] = *(const LAS bf16x8*)(lds + PG8_SA(b, h) + aoff + m * 2048 + k * 1024); } while (0)
#define PG8_LDB(dst, b, h) do { _Pragma("unroll") for (int n = 0; n < 2; ++n) _Pragma("unroll") for (int k = 0; k < 2; ++k) dst[n][k] = *(const LAS bf16x8*)(lds + PG8_SB(b, h) + boff + n * 2048 + k * 1024); } while (0)
#define PG8_MMA(ai, bj, At, Bt) do { __builtin_amdgcn_s_setprio(1); _Pragma("unroll") for (int m = 0; m < 4; ++m) _Pragma("unroll") for (int n = 0; n < 2; ++n) _Pragma("unroll") for (int k = 0; k < 2; ++k) \
        acc[ai][bj][m][n] = __builtin_amdgcn_mfma_f32_16x16x32_bf16(Bt[n][k], At[m][k], acc[ai][bj][m][n], 0, 0, 0); __builtin_amdgcn_s_setprio(0); } while (0)
#define PG8_WAIT_V(n) asm volatile("s_waitcnt vmcnt(" #n ")" ::: "memory")
#define PG8_WAIT_L(n) asm volatile("s_waitcnt lgkmcnt(" #n ")" ::: "memory")
#define PG8_BAR __builtin_amdgcn_s_barrier()
#define PG8_SCHED __builtin_amdgcn_sched_barrier(0)
    Unit cur, nxt; int ui = 0;
    if (!S.next(0, cur)) return;
    f32x4 acc[2][2][4][2];
#pragma unroll
    for (int a = 0; a < 2; ++a)
#pragma unroll
        for (int b = 0; b < 2; ++b)
#pragma unroll
            for (int m = 0; m < 4; ++m)
#pragma unroll
                for (int n = 0; n < 2; ++n) acc[a][b][m][n] = (f32x4){0.f, 0.f, 0.f, 0.f};
    bf16x8 At[4][2], B0[2][2], B1[2][2];
    const char* cA = (const char*)g.A + (size_t)cur.pm * tstep; const char* cB = (const char*)g.Bt + (size_t)cur.pn * tstep;
    PG8_STAGE(PG8_SB(0, 0), cB, voffA); PG8_STAGE(PG8_SA(0, 0), cA, voffA); PG8_STAGE(PG8_SB(0, 1), cB + hstep, voffA); PG8_STAGE(PG8_SA(0, 1), cA + hstep, voffA);
    if (wr == 1) PG8_BAR;
    PG8_WAIT_V(4); PG8_BAR;
    PG8_STAGE(PG8_SB(1, 0), cB + kstep, voffA); PG8_STAGE(PG8_SA(1, 0), cA + kstep, voffA); PG8_STAGE(PG8_SB(1, 1), cB + hstep + kstep, voffA);
    PG8_WAIT_V(6); PG8_BAR;
    for (;;) {
        const bool has_next = S.next(ui + 1, nxt);
        const char* nA = has_next ? (const char*)g.A + (size_t)nxt.pm * tstep : cA; const char* nB = has_next ? (const char*)g.Bt + (size_t)nxt.pn * tstep : cB;
        for (int t = 0; t < nt; t += 2) {
            const bool last = (t == nt - 2);
            const char* a1 = cA + (size_t)(t + 1) * kstep;
            const char* a2 = last ? nA : cA + (size_t)(t + 2) * kstep; const char* b2 = last ? nB : cB + (size_t)(t + 2) * kstep;
            const char* a3 = a2 + kstep; const char* b3 = b2 + kstep;
            PG8_LDB(B0, 0, 0); PG8_SCHED; PG8_LDA(At, 0, 0); PG8_STAGE(PG8_SA(1, 1), a1 + hstep, voffA);
            PG8_WAIT_L(8); PG8_BAR; PG8_WAIT_L(0); PG8_MMA(0, 0, At, B0); PG8_BAR; PG8_SCHED;
            PG8_LDB(B1, 0, 1); PG8_STAGE(PG8_SB(0, 0), b2, voffA);
            PG8_BAR; PG8_WAIT_L(0); PG8_MMA(0, 1, At, B1); PG8_BAR;
            PG8_LDA(At, 0, 1); PG8_STAGE(PG8_SA(0, 0), a2, voffA);
            PG8_BAR; PG8_WAIT_L(0); PG8_MMA(1, 0, At, B0); PG8_BAR; PG8_SCHED;
            PG8_STAGE(PG8_SB(0, 1), b2 + hstep, voffA);
            PG8_WAIT_V(6); PG8_BAR; PG8_MMA(1, 1, At, B1); PG8_BAR;
            PG8_LDB(B0, 1, 0); PG8_SCHED; PG8_LDA(At, 1, 0); PG8_STAGE(PG8_SA(0, 1), a2 + hstep, voffA);
            PG8_WAIT_L(8); PG8_BAR; PG8_WAIT_L(0); PG8_MMA(0, 0, At, B0); PG8_BAR; PG8_SCHED;
            PG8_LDB(B1, 1, 1); PG8_STAGE(PG8_SB(1, 0), b3, voffA);
            PG8_BAR; PG8_WAIT_L(0); PG8_MMA(0, 1, At, B1); PG8_BAR;
            PG8_LDA(At, 1, 1); PG8_STAGE(PG8_SA(1, 0), a3, voffA);
            PG8_BAR; PG8_WAIT_L(0); PG8_MMA(1, 0, At, B0); PG8_BAR; PG8_SCHED;
            PG8_STAGE(PG8_SB(1, 1), b3 + hstep, voffA);
            PG8_WAIT_V(6); PG8_BAR; PG8_MMA(1, 1, At, B1); PG8_BAR;
        }
        if constexpr (!Epi::AFTER_DRAIN) E(acc, cur, wr, wc, fr, fq);
        if (!has_next) break;
#pragma unroll
        for (int a = 0; a < 2; ++a)
#pragma unroll
            for (int b = 0; b < 2; ++b)
#pragma unroll
                for (int m = 0; m < 4; ++m)
#pragma unroll
                    for (int n = 0; n < 2; ++n) acc[a][b][m][n] = (f32x4){0.f, 0.f, 0.f, 0.f};
        cur = nxt; cA = nA; cB = nB; ++ui;
    }
    PG8_WAIT_V(0);
    if (wr == 0) PG8_BAR;
    PG8_BAR;
    if constexpr (Epi::AFTER_DRAIN) E.fused(acc, cur, wr, wc, fr, fq, smem);
#undef PG8_SA
#undef PG8_SB
#undef PG8_STAGE
#undef PG8_LDA
#undef PG8_LDB
#undef PG8_MMA
#undef PG8_WAIT_V
#undef PG8_WAIT_L
#undef PG8_BAR
#undef PG8_SCHED
}

__device__ __forceinline__ int win_src_col(int np) {
    const int tile = np >> 8, s = np & 255;
    if (tile < 2 || tile == 4 || tile == 5) return np;
    if (tile < 4) { const int bj = s >> 7, wc = (s >> 5) & 3, i = s & 31; return 512 + (tile - 2) * 256 + wc * 64 + bj * 32 + i; }
    return 1536 + (s >> 7) * 512 + (tile - 6) * 128 + (s & 127);
}
template <bool PERMW, bool PERM32>
__device__ __forceinline__ void transpose_cvt(const float* __restrict__ src, bf16_t* __restrict__ dst, int K, int N, float* T, int& tile_ctr, int blk, int nblk) {
    const int tid = fresh_tid(), nkt = K / 64, ntiles = nkt * (N / 256);
    int tl0 = (blk - tile_ctr) % nblk; if (tl0 < 0) tl0 += nblk;
    tile_ctr += ntiles;
    for (int tl = tl0; tl < ntiles; tl += nblk) {
        const int k0 = (tl % nkt) * 64, n0 = (tl / nkt) * 256;
        { const int n4 = (tid & 63) * 4, sc = PERMW ? win_src_col(n0 + n4) : n0 + n4; f32x4 v[8];
#pragma unroll
          for (int i = 0; i < 8; ++i) { const int k = (tid >> 6) + 8 * i; v[i] = *(const f32x4*)(src + (size_t)(k0 + k) * N + sc); }
#pragma unroll
          for (int i = 0; i < 8; ++i) { const int k = (tid >> 6) + 8 * i; *(f32x4*)(T + k * 256 + (n4 ^ (((k >> 3) & 7) << 2))) = v[i]; } }
        __syncthreads();
#pragma unroll
        for (int i = 0; i < 4; ++i) { const int pi = tid + 512 * i, q = pi & 7, nl = pi >> 3, x = PERM32 ? (nl & ~31) + perm32(nl & 31) : nl; const float* tp = T + (8 * q) * 256 + (x ^ (q << 2)); uint4 o;
            o.x = cvt_pk_bf16(tp[0], tp[256]); o.y = cvt_pk_bf16(tp[512], tp[768]); o.z = cvt_pk_bf16(tp[1024], tp[1280]); o.w = cvt_pk_bf16(tp[1536], tp[1792]);
            *(uint4*)(dst + (size_t)(n0 + nl) * K + k0 + 8 * q) = o; }
        __syncthreads();
    }
}
__device__ __forceinline__ void mod_phase(const Params& p, const bf16_t* __restrict__ Sb, float* smem) {
    const int tid = fresh_tid(), w = tid >> 6, lane = tid & 63, fr = lane & 15, fq = lane >> 4;
    f32x4* red = (f32x4*)smem; float* mod = (float*)(p.ws + WS_MOD);
    for (int it = blockIdx.x; it < NMOD / 32; it += gridDim.x) {
        const int col0 = it * 32;
        f32x4 acc[2][9];
#pragma unroll
        for (int i = 0; i < 9; ++i) { acc[0][i] = (f32x4){0.f, 0.f, 0.f, 0.f}; acc[1][i] = (f32x4){0.f, 0.f, 0.f, 0.f}; }
        Frag wfA[4], wfB[4];
#pragma unroll
        for (int kk = 0; kk < 4; ++kk) { const float* wp = p.w_ada + (size_t)(w * 128 + kk * 32 + fq * 8) * NMOD + col0 + 2 * fr;
#pragma unroll
            for (int i = 0; i < 4; ++i) { const float2 v0 = *(const float2*)(wp + (size_t)(2 * i) * NMOD), v1 = *(const float2*)(wp + (size_t)(2 * i + 1) * NMOD);
                wfA[kk].u[i] = cvt_pk_bf16(v0.x, v1.x); wfB[kk].u[i] = cvt_pk_bf16(v0.y, v1.y); } }
#pragma unroll
        for (int kk = 0; kk < 4; ++kk) {
#pragma unroll
            for (int bt = 0; bt < 9; ++bt) { Frag sf; sf.q = *(const uint4*)(Sb + (size_t)(bt * 16 + fr) * DM + w * 128 + kk * 32 + fq * 8);
                acc[0][bt] = __builtin_amdgcn_mfma_f32_16x16x32_bf16(wfA[kk].v, sf.v, acc[0][bt], 0, 0, 0);
                acc[1][bt] = __builtin_amdgcn_mfma_f32_16x16x32_bf16(wfB[kk].v, sf.v, acc[1][bt], 0, 0, 0); } }
        if (w >= 4) {
#pragma unroll
            for (int bt = 0; bt < 9; ++bt) { red[((w - 4) * 18 + bt) * 64 + lane] = acc[0][bt]; red[((w - 4) * 18 + 9 + bt) * 64 + lane] = acc[1][bt]; } }
        __syncthreads();
        if (w < 4) {
#pragma unroll
            for (int bt = 0; bt < 9; ++bt) { acc[0][bt] += red[(w * 18 + bt) * 64 + lane]; acc[1][bt] += red[(w * 18 + 9 + bt) * 64 + lane]; } }
        __syncthreads();
        if (w < 4) {
#pragma unroll
            for (int bt = 0; bt < 9; ++bt) { red[(w * 18 + bt) * 64 + lane] = acc[0][bt]; red[(w * 18 + 9 + bt) * 64 + lane] = acc[1][bt]; } }
        __syncthreads();
        for (int idx = tid; idx < 9 * 64; idx += 512) { const int bt = idx >> 6, l = idx & 63; f32x4 sa = red[bt * 64 + l], sb = red[(9 + bt) * 64 + l];
#pragma unroll
            for (int w2 = 1; w2 < 4; ++w2) { sa += red[(w2 * 18 + bt) * 64 + l]; sb += red[(w2 * 18 + 9 + bt) * 64 + l]; }
            const int b = bt * 16 + (l & 15), j = col0 + (l >> 4) * 8;
            if (b < NB) { float* mp = mod + (size_t)b * NMOD + j;
                *(f32x4*)mp = (f32x4){sa[0], sb[0], sa[1], sb[1]} + *(const f32x4*)(p.b_ada + j);
                *(f32x4*)(mp + 4) = (f32x4){sa[2], sb[2], sa[3], sb[3]} + *(const f32x4*)(p.b_ada + j + 4); } }
        __syncthreads();
    }
}
template <bool FINAL, bool WT = false>
__device__ __forceinline__ void rownorm_phase(const Params& p, const float* g, int sh_off, int sc_off, bool from_out, int r0 = 0, int r1 = NTOK, int nblk = 0) {
    const int tid = fresh_tid(), lane = tid & 63, gw = blockIdx.x * 8 + (tid >> 6), nw = (nblk ? nblk : (int)gridDim.x) * 8;
    const float* mod = (const float*)(p.ws + WS_MOD); bf16_t* H = (bf16_t*)(p.ws + WS_H);
    f32x4 gv[4];
#pragma unroll
    for (int i = 0; i < 4; ++i) gv[i] = *(const f32x4*)(g + (i >> 1) * 512 + lane * 8 + (i & 1) * 4);
    for (int rowb = r0 + gw; rowb < r1; rowb += 4 * nw) {
        f32x4 v[4][4];
#pragma unroll
        for (int q = 0; q < 4; ++q) { const int row = rowb + q * nw;
            if (row < r1) { const float* src = from_out ? p.out + (size_t)row * DM : (row < NP ? p.x_prompt + (size_t)row * DM : p.x_sample + (size_t)(row - NP) * DM);
#pragma unroll
                for (int i = 0; i < 4; ++i) v[q][i] = *(const f32x4*)(src + (i >> 1) * 512 + lane * 8 + (i & 1) * 4); }
            else {
#pragma unroll
                for (int i = 0; i < 4; ++i) v[q][i] = (f32x4){0.f, 0.f, 0.f, 0.f}; } }
        __builtin_amdgcn_sched_barrier(0);
        float rs[4];
#pragma unroll
        for (int q = 0; q < 4; ++q) { float ss = 0.f;
#pragma unroll
            for (int i = 0; i < 4; ++i) ss += v[q][i][0] * v[q][i][0] + v[q][i][1] * v[q][i][1] + v[q][i][2] * v[q][i][2] + v[q][i][3] * v[q][i][3];
#pragma unroll
            for (int o = 1; o < 64; o <<= 1) ss += __shfl_xor(ss, o);
            rs[q] = rsqrtf(ss * (1.f / DM) + EPS); }
#pragma unroll
        for (int q = 0; q < 4; ++q) { const int row = rowb + q * nw;
            if (row < r1) { const float* mb = mod + (size_t)batch_of(row) * NMOD;
#pragma unroll
                for (int h = 0; h < 2; ++h) { const int c = h * 512 + lane * 8;
                    const f32x4 y0 = v[q][2 * h] * rs[q] * gv[2 * h], y1 = v[q][2 * h + 1] * rs[q] * gv[2 * h + 1];
                    if (FINAL) { *(f32x4*)(p.out + (size_t)row * DM + c) = y0; *(f32x4*)(p.out + (size_t)row * DM + c + 4) = y1; }
                    else { if (WT) st_wt_bf16x8(H + (size_t)row * DM + c, y0 * (*(const f32x4*)(mb + sc_off + c) + 1.f) + *(const f32x4*)(mb + sh_off + c),
                                                             y1 * (*(const f32x4*)(mb + sc_off + c + 4) + 1.f) + *(const f32x4*)(mb + sh_off + c + 4)); else st_bf16x8(H + (size_t)row * DM + c, y0 * (*(const f32x4*)(mb + sc_off + c) + 1.f) + *(const f32x4*)(mb + sh_off + c),
                                                             y1 * (*(const f32x4*)(mb + sc_off + c + 4) + 1.f) + *(const f32x4*)(mb + sh_off + c + 4)); } } } }
    }
}
__device__ __forceinline__ void p1_prompt_rows(const Params& p) {
    const int tid = fresh_tid(), lane = tid & 63, gw = blockIdx.x * 8 + (tid >> 6);
    const float* mb = (const float*)(p.ws + WS_MOD) + (size_t)(gw >> 8) * NMOD; bf16_t* H = (bf16_t*)(p.ws + WS_H);
    f32x4 gs[4], sh[4];
#pragma unroll
    for (int i = 0; i < 4; ++i) { const int c = (i >> 1) * 512 + lane * 8 + (i & 1) * 4; gs[i] = *(const f32x4*)(p.g_mix + c) * (*(const f32x4*)(mb + 1024 + c) + 1.f); sh[i] = *(const f32x4*)(mb + c); }
#pragma unroll
    for (int trip = 0; trip < 2; ++trip) { const int rowb = gw * 8 + trip * 4;
        f32x4 v[4][4];
#pragma unroll
        for (int q = 0; q < 4; ++q)
#pragma unroll
            for (int i = 0; i < 4; ++i) v[q][i] = *(const f32x4*)(p.x_prompt + (size_t)(rowb + q) * DM + (i >> 1) * 512 + lane * 8 + (i & 1) * 4);
        __builtin_amdgcn_sched_barrier(0);
#pragma unroll
        for (int q = 0; q < 4; ++q) { float ss = 0.f;
#pragma unroll
            for (int i = 0; i < 4; ++i) ss += v[q][i][0] * v[q][i][0] + v[q][i][1] * v[q][i][1] + v[q][i][2] * v[q][i][2] + v[q][i][3] * v[q][i][3];
#pragma unroll
            for (int o = 1; o < 64; o <<= 1) ss += __shfl_xor(ss, o);
            const float rs = rsqrtf(ss * (1.f / DM) + EPS);
#pragma unroll
            for (int h = 0; h < 2; ++h) st_bf16x8(H + (size_t)(rowb + q) * DM + h * 512 + lane * 8, v[q][2 * h] * rs * gs[2 * h] + sh[2 * h], v[q][2 * h + 1] * rs * gs[2 * h + 1] + sh[2 * h + 1]); }
    }
}
__device__ __forceinline__ void mixer_phase(const Params& p, unsigned char* smem) {
    const int tid = fresh_tid(), w = tid >> 6, lane = tid & 63, fr = lane & 15, fq = lane >> 4;
    const bf16_t* pU = (const bf16_t*)(p.ws + WS_PU); const bf16_t* pV = (const bf16_t*)(p.ws + WS_PV); const bf16_t* pBG = (const bf16_t*)(p.ws + WS_PBG); const bf16_t* pZ = (const bf16_t*)(p.ws + WS_PZ);
    bf16_t* mA = (bf16_t*)(p.ws + WS_MA); const bf16_t* Wt = (const bf16_t*)(p.ws + WS_WTRIL);
    bf16_t* Vs = (bf16_t*)smem;
    for (int item = blockIdx.x; item < 256; item += gridDim.x) {
        const int hh = item & 1, bc = item >> 1, row0 = (bc >> 4) * 2048 + (bc & 15) * 128;
#pragma unroll
        for (int i = 0; i < 8; ++i) { const int pi = tid + 512 * i, s = pi >> 5, c16 = pi & 31, hl = c16 >> 3, d = (c16 & 7) * 8;
            *(uint4*)(Vs + ((hl * 128 + s) * 72 + d)) = *(const uint4*)(pV + (size_t)(row0 + s) * 512 + hh * 256 + c16 * 8); }
        __syncthreads();
        const int hl = w >> 1, thalf = w & 1, head = hh * 4 + hl;
        f32x4 acc[4][4];
#pragma unroll
        for (int a = 0; a < 4; ++a)
#pragma unroll
            for (int b = 0; b < 4; ++b) acc[a][b] = (f32x4){0.f, 0.f, 0.f, 0.f};
#pragma unroll
        for (int ks = 0; ks < 4; ++ks) {
            if (ks < 2 + 2 * thalf) {
                Frag af[4];
#pragma unroll
                for (int mt = 0; mt < 4; ++mt) af[mt].q = *(const uint4*)(Wt + ((size_t)(head * 128 + thalf * 64 + mt * 16 + fr) * 128 + ks * 32 + fq * 8));
#pragma unroll
                for (int nt = 0; nt < 4; ++nt) { Frag bf; const bf16_t* vp = Vs + ((hl * 128 + ks * 32 + fq * 8) * 72 + (nt >> 1) * 32 + perm32((nt & 1) * 16 + fr));
#pragma unroll
                    for (int i = 0; i < 4; ++i) bf.u[i] = (unsigned)vp[(2 * i) * 72] | ((unsigned)vp[(2 * i + 1) * 72] << 16);
#pragma unroll
                    for (int mt = 0; mt < 4; ++mt) acc[mt][nt] = __builtin_amdgcn_mfma_f32_16x16x32_bf16(bf.v, af[mt].v, acc[mt][nt], 0, 0, 0); }
            }
        }
#pragma unroll
        for (int mt = 0; mt < 4; ++mt) { const int t = thalf * 64 + mt * 16 + fr, row = row0 + t; const float bias = p.b_s[head * 128 + t];
#pragma unroll
            for (int pp = 0; pp < 2; ++pp) { const int col = head * 64 + pp * 32 + fq * 8; float u[8]; unpack8(*(const uint4*)(pU + (size_t)row * 512 + col), u);
                f32x4 o0 = acc[mt][2 * pp] + bias, o1 = acc[mt][2 * pp + 1] + bias;
#pragma unroll
                for (int j = 0; j < 4; ++j) { o0[j] *= u[j]; o1[j] *= u[4 + j]; }
                st_bf16x8(mA + (size_t)row * DM + col, o0, o1); } }
        __syncthreads();
    }
    for (int idx = blockIdx.x * 512 + tid; idx < (NP / 8) * 64; idx += gridDim.x * 512) {
        const int row0 = (idx >> 6) * 8, c = (idx & 63) * 8, t0 = row0 & 2047;
        uint4 zq[10], bq[8];
#pragma unroll
        for (int i = 0; i < 10; ++i) { zq[i] = make_uint4(0u, 0u, 0u, 0u); if (i >= 2 || t0 > 0) zq[i] = *(const uint4*)(pZ + (size_t)(row0 + i - 2) * 512 + c); }
#pragma unroll
        for (int i = 0; i < 8; ++i) bq[i] = *(const uint4*)(pBG + (size_t)(row0 + i) * 512 + c);
        float w0[8], w1[8], w2[8];
#pragma unroll
        for (int j = 0; j < 8; ++j) { w0[j] = p.w_conv[c + j]; w1[j] = p.w_conv[512 + c + j]; w2[j] = p.w_conv[1024 + c + j]; }
#pragma unroll
        for (int i = 0; i < 8; ++i) { float za[8], zb[8], zc[8], bg[8], y[8];
            unpack8(zq[i], za); unpack8(zq[i + 1], zb); unpack8(zq[i + 2], zc); unpack8(bq[i], bg);
#pragma unroll
            for (int j = 0; j < 8; ++j) y[j] = bg[j] * (w0[j] * za[j] + w1[j] * zb[j] + w2[j] * zc[j]);
            uint4 o; o.x = cvt_pk_bf16(y[0], y[1]); o.y = cvt_pk_bf16(y[2], y[3]); o.z = cvt_pk_bf16(y[4], y[5]); o.w = cvt_pk_bf16(y[6], y[7]);
            *(uint4*)(mA + (size_t)(row0 + i) * DM + 512 + c) = o; }
    }
    for (int idx = blockIdx.x * 512 + tid; idx < 128 * 64; idx += gridDim.x * 512) {
        const int i = idx >> 6, row = NP + i, c = (idx & 63) * 8;
        float z[8], bg[8], z1[8], z2[8], y[8], u[8], v[8];
        unpack8(*(const uint4*)(pZ + (size_t)row * 512 + c), z); unpack8(*(const uint4*)(pBG + (size_t)row * 512 + c), bg);
        unpack8(*(const uint4*)(pU + (size_t)row * 512 + c), u); unpack8(*(const uint4*)(pV + (size_t)row * 512 + c), v);
        const float* sp = p.state_conv + (size_t)i * 1024 + c;
#pragma unroll
        for (int j = 0; j < 8; ++j) { z2[j] = sp[j]; z1[j] = sp[512 + j]; }
        float* oc = p.out + O_CONVS + (size_t)i * 1024 + c;
        *(f32x4*)oc = (f32x4){z1[0], z1[1], z1[2], z1[3]}; *(f32x4*)(oc + 4) = (f32x4){z1[4], z1[5], z1[6], z1[7]};
        const int h = c >> 6; const float w00 = p.w_s[(size_t)h * 128 * 128], b0 = p.b_s[h * 128];
        uint4 o; o.x = cvt_pk_bf16(u[0] * (w00 * v[0] + b0), u[1] * (w00 * v[1] + b0)); o.y = cvt_pk_bf16(u[2] * (w00 * v[2] + b0), u[3] * (w00 * v[3] + b0));
        o.z = cvt_pk_bf16(u[4] * (w00 * v[4] + b0), u[5] * (w00 * v[5] + b0)); o.w = cvt_pk_bf16(u[6] * (w00 * v[6] + b0), u[7] * (w00 * v[7] + b0));
        *(uint4*)(mA + (size_t)row * DM + c) = o;
#pragma unroll
        for (int j = 0; j < 8; ++j) y[j] = bg[j] * (p.w_conv[c + j] * z2[j] + p.w_conv[512 + c + j] * z1[j] + p.w_conv[1024 + c + j] * z[j]);
        o.x = cvt_pk_bf16(y[0], y[1]); o.y = cvt_pk_bf16(y[2], y[3]); o.z = cvt_pk_bf16(y[4], y[5]); o.w = cvt_pk_bf16(y[6], y[7]);
        *(uint4*)(mA + (size_t)row * DM + 512 + c) = o;
    }
}

__global__ __launch_bounds__(512, 2) void fwd_megakernel(Params p) {
    extern __shared__ __attribute__((aligned(16))) unsigned char shm[];
    __shared__ uint4 xb_words;
    cg::grid_group grid = cg::this_grid();
    LAS unsigned char* lds = (LAS unsigned char*)shm;
    const int tid = fresh_tid(), G = gridDim.x, bid = blockIdx.x;
    if (tid == 0) xb_words = make_uint4(0u, 0u, 0u, 0u);
    __syncthreads();
    const XcdBarrier xb = xcd_barrier_post((unsigned*)(p.ws + WS_BAR), (volatile LAS unsigned*)&xb_words);
    bf16_t* WinT = (bf16_t*)(p.ws + WS_WIN); bf16_t* WoutT = (bf16_t*)(p.ws + WS_WOUT); bf16_t* Wff1T = (bf16_t*)(p.ws + WS_WFF1); bf16_t* Wff2T = (bf16_t*)(p.ws + WS_WFF2);
    bf16_t* WadaT = (bf16_t*)(p.ws + WS_WADA); bf16_t* Sb = (bf16_t*)(p.ws + WS_S);
    bf16_t* H = (bf16_t*)(p.ws + WS_H); bf16_t* mA = (bf16_t*)(p.ws + WS_MA); bf16_t* T = (bf16_t*)(p.ws + WS_R);
    float* mod = (float*)(p.ws + WS_MOD);
    { unsigned* cs = (unsigned*)(p.ws + WS_CNT) + CNT_S * 64;
      for (int i = bid * 512 + tid; i < 144 * DM / 8; i += G * 512) { const int b = i >> 7, k = (i & 127) * 8; uint4 o = {0u, 0u, 0u, 0u};
          if (b < NB) { const float* cp = (b < 8 ? p.c_prompt + (size_t)b * DM : p.c_sample + (size_t)(b - 8) * DM) + k; const f32x4 c0 = *(const f32x4*)cp, c1 = *(const f32x4*)(cp + 4);
              o.x = cvt_pk_bf16(silu_f(c0[0]), silu_f(c0[1])); o.y = cvt_pk_bf16(silu_f(c0[2]), silu_f(c0[3])); o.z = cvt_pk_bf16(silu_f(c1[0]), silu_f(c1[1])); o.w = cvt_pk_bf16(silu_f(c1[2]), silu_f(c1[3])); }
          *(uint4*)(Sb + (size_t)b * DM + k) = o; }
      if (bid < 144 * DM / 8 / 512) { asm volatile("s_waitcnt vmcnt(0)" ::: "memory"); __syncthreads();
          if (fresh_tid() == 0) { __builtin_amdgcn_fence(__ATOMIC_RELEASE, "agent"); asm volatile("s_waitcnt vmcnt(0)" ::: "memory"); xb_add(cs, 1u); } }
      bf16_t* Wt = (bf16_t*)(p.ws + WS_WTRIL);
      for (int i = bid * 512 + tid; i < 8 * 128 * 128; i += G * 512) { const int t = (i >> 7) & 127, s = i & 127; Wt[i] = (bf16_t)(cvt_pk_bf16(s <= t ? p.w_s[i] : 0.f, 0.f) & 0xffffu); }
      { const int nslot = (bid < NMOD / 32) ? 1 : 3, slot0 = (bid < NMOD / 32) ? bid : NMOD / 32 + 3 * (bid - NMOD / 32), nslots = NMOD / 32 + 3 * (G - NMOD / 32);
#pragma unroll 1
        for (int j = 0; j < nslot; ++j) { int ctr = 0;
          transpose_cvt<true, true>(p.w_in, WinT, DM, DIN, (float*)shm, ctr, slot0 + j, nslots);
          transpose_cvt<false, true>(p.w_out, WoutT, DM, DM, (float*)shm, ctr, slot0 + j, nslots);
          transpose_cvt<false, true>(p.w_ff2, Wff2T, DFF, DM, (float*)shm, ctr, slot0 + j, nslots);
          transpose_cvt<false, true>(p.w_ff1, Wff1T, DM, DFF, (float*)shm, ctr, slot0 + j, nslots); } }
      if (p.use_cg_sync) grid.sync();
      asm volatile("s_waitcnt vmcnt(0)" ::: "memory"); __syncthreads();
      if (fresh_tid() == 0) { asm volatile("buffer_inv sc1" ::: "memory"); spin_until(cs, 144 * DM / 8 / 512); asm volatile("s_waitcnt vmcnt(0)" ::: "memory"); }
      __syncthreads();
      mod_phase(p, Sb, (float*)shm); }
    xcd_barrier(xb);
    for (int rep = 0; rep < ((DUP >> 2) & 1) + 1; ++rep) {
    p1_prompt_rows(p);
    rownorm_phase<false>(p, p.g_mix, 0, 1024, false, NP, NTOK);
    }
    xcd_barrier(xb);
    { StaticOrder S; S.init(NP, DIN, G, bid, WGM_G1); Gemm g{H, WinT, NP, DIN, DM};
      EpiIn E{(bf16_t*)(p.ws + WS_PU), (bf16_t*)(p.ws + WS_PV), (bf16_t*)(p.ws + WS_PBG), (bf16_t*)(p.ws + WS_PZ), p.g_v, p.out};
      gemm_phase(lds, g, S, E);
      if (DUP & 8) gemm_phase(lds, g, S, E);
      small_gemm(H + (size_t)NP * DM, 8, WinT, DIN, DM, E, NP, (float*)shm, G == 256 ? bid - 128 : bid, G == 256 ? 128 : G);
      { const int blk = G == 256 ? bid - 128 : bid, nblk = G == 256 ? 128 : G;
        if (blk >= 0) { int ctr = 0;

 } } }
    xcd_barrier(xb);
    for (int rep = 0; rep < ((DUP >> 4) & 1) + 1; ++rep) {
    mixer_phase(p, shm);
    }
    xcd_barrier(xb);
    { StaticOrder S; S.init(NP, DM, G, bid); Gemm g{mA, WoutT, NP, DM, DM};
      EpiRes E{p.x_prompt, p.x_sample, mod, p.out, 2048, 0};
#if FUSE4
      EpiFused<0> EF{p.x_prompt, mod, p.g_ffn, p.out, H, (float*)(p.ws + WS_SLOT), (unsigned*)(p.ws + WS_CNT) + CNT_P4 * 64, (bf16_t*)(p.ws + WS_X1B)};
      gemm_phase(lds, g, S, EF, (float*)shm);
#else
      gemm_phase(lds, g, S, E);
#endif
      small_gemm_w<4, 8>(mA + (size_t)NP * DM, 8, WoutT, DM, DM, E, NP, (float*)shm); }
    xcd_barrier(xb);
#if !FUSE4
    rownorm_phase<false>(p, p.g_ffn, 3072, 4096, true);
    xcd_barrier(xb);
#endif
    { unsigned* ready6 = (unsigned*)(p.ws + WS_CNT) + CNT_READY6 * 64;
#if FUSE4
      if (bid < 16) {
          rownorm_phase<false, true>(p, p.g_ffn, 3072, 4096, true, NP, NTOK, 16);
          asm volatile("s_waitcnt vmcnt(0)" ::: "memory"); __syncthreads();
          if (fresh_tid() == 0) xb_add(ready6, 1u); }
#endif
      StaticOrder S; S.init(NP, DFF, G, bid, WGM_G3); Gemm g{H, Wff1T, NP, DFF, DM};
      EpiRelu2 E{T};
      gemm_phase(lds, g, S, E);
#if FUSE4
      if (fresh_tid() == 0) { spin_until(ready6, 16u); __builtin_amdgcn_fence(__ATOMIC_ACQUIRE, "agent"); asm volatile("s_waitcnt vmcnt(0)" ::: "memory"); }
      __syncthreads();
#endif
      small_gemm_w<1, 16, true>(H + (size_t)NP * DM, 8, Wff1T, DFF, DM, E, NP, (float*)shm); }
    xcd_barrier(xb);
    { unsigned* done7 = (unsigned*)(p.ws + WS_CNT) + CNT_DONE7 * 64;
      StaticOrder S; S.init(NP, DM, G, bid); Gemm g{T, Wff2T, NP, DM, DFF};
      EpiRes E{p.x_prompt, p.x_sample, mod, p.out, 5120, 1};
#if FUSE7
      small_gemm_w<4, 16>(T + (size_t)NP * DFF, 8, Wff2T, DM, DFF, E, NP, (float*)shm);
      asm volatile("s_waitcnt vmcnt(0)" ::: "memory"); __syncthreads();
      if (fresh_tid() == 0) xb_add(done7, 1u);
      EpiFused<1> EF{p.x_prompt, mod, p.g_final, p.out, H, (float*)(p.ws + WS_SLOT) + 64 * 4 * 256, (unsigned*)(p.ws + WS_CNT) + CNT_P7 * 64, (bf16_t*)(p.ws + WS_X1B)};
      gemm_phase(lds, g, S, EF, (float*)shm);
      if (bid < 16) {
          if (fresh_tid() == 0) { spin_until(done7, (unsigned)G); __builtin_amdgcn_fence(__ATOMIC_ACQUIRE, "agent"); asm volatile("s_waitcnt vmcnt(0)" ::: "memory"); }
          __syncthreads();
          rownorm_phase<true>(p, p.g_final, 0, 0, true, NP, NTOK, 16); }
#else
      gemm_phase(lds, g, S, E);
      small_gemm_w<4, 16>(T + (size_t)NP * DFF, 8, Wff2T, DM, DFF, E, NP, (float*)shm);
#endif
    }
#if !FUSE7
    xcd_barrier(xb);
    rownorm_phase<true>(p, p.g_final, 0, 0, true);
#endif
}

extern "C" void kernel_launch(void* const* d_in, const int* in_sizes, int n_in, void* d_out, int out_size, void* d_ws, size_t ws_size, hipStream_t stream) {
    static int grid = 0;
    if (grid == 0) {
        if (n_in != 18 || in_sizes[0] != NP * DM || (size_t)out_size != O_END || ws_size < WS_END) {
            fprintf(stderr, "kernel_launch: unexpected shapes (n_in %d, in0 %d, out %d, ws %zu, need %zu)\n", n_in, n_in > 0 ? in_sizes[0] : -1, out_size, ws_size, (size_t)WS_END); grid = -1; return; }
        int dev = 0, cus = 0, per_cu = 0;
        (void)hipGetDevice(&dev); (void)hipDeviceGetAttribute(&cus, hipDeviceAttributeMultiprocessorCount, dev);
        if (hipFuncSetAttribute((const void*)fwd_megakernel, hipFuncAttributeMaxDynamicSharedMemorySize, LDS_BYTES) != hipSuccess) { fprintf(stderr, "kernel_launch: hipFuncSetAttribute failed\n"); grid = -1; return; }
        if (hipOccupancyMaxActiveBlocksPerMultiprocessor(&per_cu, (const void*)fwd_megakernel, 512, LDS_BYTES) != hipSuccess || per_cu < 1) { fprintf(stderr, "kernel_launch: occupancy query failed (%d)\n", per_cu); grid = -1; return; }
        grid = cus * per_cu;
        if (grid != 256) { fprintf(stderr, "kernel_launch: built for 256 co-resident workgroups, got %d\n", grid); grid = -1; return; }
    }
    if (grid < 0) return;
    Params p{};
    p.x_prompt = (const float*)d_in[0]; p.x_sample = (const float*)d_in[1]; p.c_prompt = (const float*)d_in[2]; p.c_sample = (const float*)d_in[3]; p.state_conv = (const float*)d_in[4];
    p.g_mix = (const float*)d_in[5]; p.w_ada = (const float*)d_in[6]; p.b_ada = (const float*)d_in[7]; p.w_in = (const float*)d_in[8]; p.g_v = (const float*)d_in[9];
    p.w_s = (const float*)d_in[10]; p.b_s = (const float*)d_in[11]; p.w_conv = (const float*)d_in[12]; p.w_out = (const float*)d_in[13]; p.g_ffn = (const float*)d_in[14];
    p.w_ff1 = (const float*)d_in[15]; p.w_ff2 = (const float*)d_in[16]; p.g_final = (const float*)d_in[17];
    p.out = (float*)d_out; p.ws = (unsigned char*)d_ws;
    if (hipMemsetAsync((char*)d_ws + WS_BAR, 0, 16384 + CNT_BYTES, stream) != hipSuccess) { fprintf(stderr, "kernel_launch: memset failed\n"); return; }
    void* args[] = {&p};
    hipError_t e = hipLaunchCooperativeKernel((const void*)fwd_megakernel, dim3(grid), dim3(512), args, LDS_BYTES, stream);
    if (e != hipSuccess) fprintf(stderr, "cooperative launch failed: %s (grid %d)\n", hipGetErrorString(e), grid);
}
```

```cpp
#include <hip/hip_runtime.h>
#include <hip/hip_cooperative_groups.h>
#include <cstdio>
namespace cg = cooperative_groups;

#define LAS __attribute__((address_space(3)))
typedef unsigned short bf16_t;
typedef short bf16x8 __attribute__((ext_vector_type(8)));
typedef float f32x4 __attribute__((ext_vector_type(4)));

constexpr int DM = 1024, NP = 16384, NTOK = 16512, MPAD = 16640, NB = 136, NMOD = 6144, DIN = 2560, DFF = 4096;
constexpr int BM = 256, BK = 64, HALF = 128, HTB = HALF * BK * 2, STAGE_BYTES = 8 * HTB, NXCD = 8, WGM = 4;
constexpr int LDS_BYTES = STAGE_BYTES;
constexpr float EPS = 1e-6f;
#define WGM_G1 8
#define WGM_G3 4
#define DUP 0

constexpr size_t WS_WIN = 0;
constexpr size_t WS_WOUT = WS_WIN + (size_t)DIN * DM * 2;
constexpr size_t WS_WFF1 = WS_WOUT + (size_t)DM * DM * 2;
constexpr size_t WS_WFF2 = WS_WFF1 + (size_t)DFF * DM * 2;
constexpr size_t WS_WTRIL = WS_WFF2 + (size_t)DM * DFF * 2;
constexpr size_t WS_MOD = WS_WTRIL + (size_t)8 * 128 * 128 * 2;
constexpr size_t WS_H = WS_MOD + (size_t)NB * NMOD * 4;
constexpr size_t WS_R = WS_H + (size_t)MPAD * DM * 2;
constexpr size_t WS_PU = WS_R;
constexpr size_t WS_PV = WS_PU + (size_t)MPAD * 512 * 2;
constexpr size_t WS_PBG = WS_PV + (size_t)MPAD * 512 * 2;
constexpr size_t WS_PZ = WS_PBG + (size_t)MPAD * 512 * 2;
constexpr size_t WS_MA = WS_PZ + (size_t)MPAD * 512 * 2;
constexpr size_t WS_WADA = WS_R + (size_t)MPAD * DFF * 2;
constexpr size_t WS_S = WS_WADA + (size_t)NMOD * DM * 2;
constexpr size_t WS_BAR = WS_S + (size_t)144 * DM * 2;
constexpr size_t WS_CNT = WS_BAR + 16384;
constexpr int CNT_BYTES = 36864, CNT_P4 = 0, CNT_P7 = 64, CNT_READY6 = 128, CNT_DONE7 = 129, CNT_S = 130;
constexpr size_t WS_SLOT = WS_CNT + CNT_BYTES;
constexpr size_t WS_X1B = WS_SLOT + (size_t)2 * 64 * 4 * 256 * 4;
constexpr size_t WS_END = WS_X1B + (size_t)NP * DM * 2;
#define FUSE4 1
#define FUSE7 1
constexpr size_t O_Y = 0, O_CONVP = (size_t)NTOK * DM, O_CONVS = O_CONVP + 8 * 2 * 512, O_VS = O_CONVS + 128 * 2 * 512, O_END = O_VS + 128 * 512;

struct Params {
    const float *x_prompt, *x_sample, *c_prompt, *c_sample, *state_conv, *g_mix, *w_ada, *b_ada, *w_in, *g_v, *w_s, *b_s, *w_conv, *w_out, *g_ffn, *w_ff1, *w_ff2, *g_final;
    float* out; unsigned char* ws; int use_cg_sync; int pad0;
};

__device__ __forceinline__ unsigned cvt_pk_bf16(float lo, float hi) { unsigned r; asm("v_cvt_pk_bf16_f32 %0, %1, %2" : "=v"(r) : "v"(lo), "v"(hi)); return r; }
__device__ __forceinline__ float bf_lo(unsigned u) { return __uint_as_float(u << 16); }
__device__ __forceinline__ float bf_hi(unsigned u) { return __uint_as_float(u & 0xffff0000u); }
__device__ __forceinline__ float gelu_tanh(float x) { const float u = 1.5957691216f * (x + 0.044715f * x * x * x); return x * __builtin_amdgcn_rcpf(1.f + __expf(-u)); }
__device__ __forceinline__ float silu_f(float x) { return x * __builtin_amdgcn_rcpf(1.f + __expf(-x)); }
__device__ __forceinline__ void st_bf16x4(bf16_t* p, f32x4 v) { uint2 o; o.x = cvt_pk_bf16(v[0], v[1]); o.y = cvt_pk_bf16(v[2], v[3]); *(uint2*)p = o; }
__device__ __forceinline__ int batch_of(int row) { return row < NP ? (row >> 11) : (row < NTOK ? 8 + row - NP : NB - 1); }
union Frag { bf16x8 v; unsigned u[4]; uint4 q; };
__device__ __forceinline__ void unpack8(const uint4 q, float (&f)[8]) { f[0] = bf_lo(q.x); f[1] = bf_hi(q.x); f[2] = bf_lo(q.y); f[3] = bf_hi(q.y); f[4] = bf_lo(q.z); f[5] = bf_hi(q.z); f[6] = bf_lo(q.w); f[7] = bf_hi(q.w); }
__device__ __forceinline__ int fresh_tid() { int t = threadIdx.x; asm volatile("" : "+v"(t)); return t; }


#define XB_TMO      128
#define XB_XCNT(j)  (256  + 64 * (j))
#define XB_XSUB(j)  (1280 + 64 * (j))
#define XB_XGEN(j)  (2304 + 64 * (j))
#define XB_TOP      3328
#define XB_TOPGEN   3392
#define XCD_BAR_WORDS 3456
#define XB_SPIN_CAP (1u << 18)
__device__ __forceinline__ unsigned xb_ld(unsigned* p)              { return __hip_atomic_load(p, __ATOMIC_RELAXED, __HIP_MEMORY_SCOPE_AGENT); }
__device__ __forceinline__ unsigned xb_add(unsigned* p, unsigned v) { return __hip_atomic_fetch_add(p, v, __ATOMIC_RELAXED, __HIP_MEMORY_SCOPE_AGENT); }
__device__ __forceinline__ unsigned xb_xcc_id() { return (unsigned)__builtin_amdgcn_s_getreg((3 << 11) | 20) & 0xFu; }
#define XB_SPIN(cond, bar) do { unsigned _sp = 0; while (cond) { __builtin_amdgcn_s_sleep(1); \
    if ((++_sp & 255u) == 0u) { if (xb_ld(&(bar)[XB_TMO])) break; if (_sp > XB_SPIN_CAP) { atomicAdd(&(bar)[XB_TMO], 1u); break; } } } } while (0)
struct XcdBarrier { unsigned* bar; unsigned x; volatile LAS unsigned* st; };
__device__ __forceinline__ XcdBarrier xcd_barrier_post(unsigned* bar, volatile LAS unsigned* st) {
    XcdBarrier b; b.bar = bar; b.x = xb_xcc_id(); b.st = st;
    if (threadIdx.x == 0) (void)xb_add(&bar[XB_XCNT(b.x)], 1u);
    return b;
}
__device__ __forceinline__ void xcd_barrier_complete(unsigned* bar, unsigned x, unsigned& nloc, unsigned& nx) {
    const unsigned G = gridDim.x * gridDim.y * gridDim.z;
    unsigned sum, cnt, mine, sp = 0u;
    for (;;) {
        sum = 0u; cnt = 0u; mine = 0u;
#pragma unroll
        for (unsigned j = 0; j < 16; ++j) { const unsigned c = xb_ld(&bar[XB_XCNT(j)]); sum += c; cnt += (c > 0u) ? 1u : 0u; mine = (j == x) ? c : mine; }
        if (sum == G) break;
        __builtin_amdgcn_s_sleep(1);
        if ((++sp & 255u) == 0u) { if (xb_ld(&bar[XB_TMO])) break; if (sp > XB_SPIN_CAP) { atomicAdd(&bar[XB_TMO], 1u); break; } }
    }
    nloc = mine > 0u ? mine : 1u; nx = cnt > 0u ? cnt : 1u;
}
__device__ __forceinline__ void xcd_barrier(const XcdBarrier& b) {
    asm volatile("s_waitcnt vmcnt(0)" ::: "memory");
    __syncthreads();
    if (threadIdx.x == 0) {
        unsigned* bar = b.bar;
        __builtin_amdgcn_s_waitcnt(0);
        unsigned nloc = b.st[0], nx = b.st[1];
        if (nloc == 0u) { xcd_barrier_complete(bar, b.x, nloc, nx); b.st[0] = nloc; b.st[1] = nx; }
        const unsigned old = xb_add(&bar[XB_XSUB(b.x)], 1u);
        const unsigned gen = old / nloc;
        if (old + 1u == (gen + 1u) * nloc) {
            __builtin_amdgcn_fence(__ATOMIC_RELEASE, "agent");
            asm volatile("s_waitcnt vmcnt(0)" ::: "memory");
            const unsigned og = xb_add(&bar[XB_TOP], 1u);
            const unsigned tg = og / nx;
            asm volatile("buffer_inv sc1" ::: "memory");
            if (og + 1u == (tg + 1u) * nx) xb_add(&bar[XB_TOPGEN], 1u);
            else XB_SPIN(xb_ld(&bar[XB_TOPGEN]) == tg, bar);
            xb_add(&bar[XB_XGEN(b.x)], 1u);
            asm volatile("s_waitcnt vmcnt(0)" ::: "memory");
        } else {
            asm volatile("buffer_inv sc1" ::: "memory");
            XB_SPIN(xb_ld(&bar[XB_XGEN(b.x)]) == gen, bar);
            asm volatile("s_waitcnt vmcnt(0)" ::: "memory");
        }
    }
    __syncthreads();
}

__device__ __forceinline__ int lds_byte(int r, int c) { const int st = (r >> 4) * 2 + (c >> 5), rr = r & 15, cc = c & 31, ob = rr * 64 + cc * 2; return st * 1024 + (ob ^ (((ob >> 9) & 1) << 5)); }
__device__ __forceinline__ void stage_rc(int b, int& R, int& C) { const int st = b / 1024, sb = b % 1024, swz = sb ^ (((sb >> 9) & 1) << 5); R = (st >> 1) * 16 + swz / 64; C = (st & 1) * 32 + (swz % 64) / 2; }

__device__ __forceinline__ int perm32(int rho) { const int n = rho >> 4, i = rho & 15; return 8 * (i >> 2) + 4 * n + (i & 3); }
__device__ __forceinline__ void st_bf16x8(bf16_t* p, const f32x4 a, const f32x4 b) { uint4 o; o.x = cvt_pk_bf16(a[0], a[1]); o.y = cvt_pk_bf16(a[2], a[3]); o.z = cvt_pk_bf16(b[0], b[1]); o.w = cvt_pk_bf16(b[2], b[3]); *(uint4*)p = o; }
typedef unsigned u32x4w __attribute__((ext_vector_type(4)));
__device__ __forceinline__ void st_wt_f32x4(float* p, const f32x4 v) { asm volatile("global_store_dwordx4 %0, %1, off sc1\n\ts_nop 1" :: "v"(p), "v"(v) : "memory"); }
__device__ __forceinline__ void st_wt_bf16x8(bf16_t* p, const f32x4 a, const f32x4 b) { const u32x4w o = {cvt_pk_bf16(a[0], a[1]), cvt_pk_bf16(a[2], a[3]), cvt_pk_bf16(b[0], b[1]), cvt_pk_bf16(b[2], b[3])};
    asm volatile("global_store_dwordx4 %0, %1, off sc1\n\ts_nop 1" :: "v"(p), "v"(o) : "memory"); }
struct Unit { int pm, pn; };
struct Gemm { const bf16_t* A; const bf16_t* Bt; int M, N, K; };
struct StaticOrder {
    int nM, nN, nwg, G, c, wgm;
    __device__ void init(int M, int N, int G_, int c_, int wgm_ = WGM) { nM = M / BM; nN = N / BM; nwg = nM * nN; G = G_; c = c_; wgm = wgm_; }
    __device__ bool next(int i, Unit& u) const {
        const long L = (long)i * G + c; if (L >= nwg) return false;
        int wgid = (int)L; { const int q = nwg / NXCD, r = nwg % NXCD, xcd = wgid % NXCD, off = wgid / NXCD; wgid = (xcd < r ? xcd * (q + 1) : r * (q + 1) + (xcd - r) * q) + off; }
        const int nig = wgm * nN, gid = wgid / nig, fm = gid * wgm, gsz = (nM - fm) < wgm ? (nM - fm) : wgm;
        u.pm = fm + ((wgid % nig) % gsz); u.pn = (wgid % nig) / gsz; return true;
    }
};

#define EPI_MAIN_CALL \
    static constexpr bool AFTER_DRAIN = false; \
    __device__ __forceinline__ void operator()(const f32x4 (&acc)[2][2][4][2], const Unit& u, int wr, int wc, int fr, int fq) const { \
        const int rowb = u.pm * BM + wr * 64 + fr; \
        _Pragma("unroll") for (int ai = 0; ai < 2; ++ai) _Pragma("unroll") for (int m = 0; m < 4; ++m) { \
            const f32x4 a[2][2] = {{acc[ai][0][m][0], acc[ai][0][m][1]}, {acc[ai][1][m][0], acc[ai][1][m][1]}}; \
            row(a, rowb + ai * HALF + m * 16, u.pn, wc, fq); } }
struct EpiIn {
    bf16_t *pU, *pV, *pBG, *pZ; const float* g_v; float* out;
    __device__ __forceinline__ void row(const f32x4 (&a)[2][2], int row, int pn, int wc, int fq) const {
        if (pn < 2 || pn == 4 || pn == 5) {
            bf16_t* dst = (pn < 2 ? pU : pBG) + (size_t)row * 512 + (pn & 1) * 256 + wc * 32 + 8 * fq;
#pragma unroll
            for (int bj = 0; bj < 2; ++bj) { f32x4 v0 = a[bj][0], v1 = a[bj][1];
                if (pn < 2) {
#pragma unroll
                    for (int j = 0; j < 4; ++j) { v0[j] = gelu_tanh(v0[j]); v1[j] = gelu_tanh(v1[j]); } }
                st_bf16x8(dst + bj * HALF, v0, v1); }
        } else if (pn < 4) {
            const int head = (pn - 2) * 4 + wc;
            f32x4 g[2][2]; float ss = 0.f;
#pragma unroll
            for (int bj = 0; bj < 2; ++bj)
#pragma unroll
                for (int n = 0; n < 2; ++n)
#pragma unroll
                    for (int j = 0; j < 4; ++j) { const float t = gelu_tanh(a[bj][n][j]); g[bj][n][j] = t; ss += t * t; }
            ss += __shfl_xor(ss, 16); ss += __shfl_xor(ss, 32);
            const float rs = rsqrtf(ss * (1.f / 64.f) + EPS);
#pragma unroll
            for (int bj = 0; bj < 2; ++bj) { const int d = head * 64 + bj * 32 + 8 * fq;
                const f32x4 v0 = g[bj][0] * rs * *(const f32x4*)(g_v + d), v1 = g[bj][1] * rs * *(const f32x4*)(g_v + d + 4);
                st_bf16x8(pV + (size_t)row * 512 + d, v0, v1);
                if (row >= NP && row < NTOK) { float* o = out + O_VS + (size_t)(row - NP) * 512 + d; *(f32x4*)o = v0; *(f32x4*)(o + 4) = v1; } }
        } else {
            const int c = (pn - 6) * 128 + wc * 32 + 8 * fq;
            const f32x4 z0 = a[0][0] * a[1][0], z1 = a[0][1] * a[1][1];
            st_bf16x8(pZ + (size_t)row * 512 + c, z0, z1);
            float* o = nullptr;
            if (row < NP) { const int t = row & 2047; if (t >= 2046) o = out + O_CONVP + (size_t)((row >> 11) * 2 + (t - 2046)) * 512 + c; }
            else if (row < NTOK) o = out + O_CONVS + (size_t)((row - NP) * 2 + 1) * 512 + c;
            if (o) { *(f32x4*)o = z0; *(f32x4*)(o + 4) = z1; }
        }
    }
    EPI_MAIN_CALL
};
struct EpiRes {
    const float *xp, *xs, *mod; float* out; int gate_off; int inplace;
    __device__ __forceinline__ void row(const f32x4 (&a)[2][2], int row, int pn, int wc, int fq) const {
        if (row < NTOK) { const int cb = pn * BM + wc * 32 + 4 * fq;
            const float* gt = mod + (size_t)batch_of(row) * NMOD + gate_off; float* orow = out + (size_t)row * DM;
            const float* br = inplace ? orow : (row < NP ? xp + (size_t)row * DM : xs + (size_t)(row - NP) * DM);
#pragma unroll
            for (int bj = 0; bj < 2; ++bj)
#pragma unroll
                for (int n = 0; n < 2; ++n) { const int c = cb + bj * HALF + n * 16;
                    *(f32x4*)(orow + c) = *(const f32x4*)(br + c) + *(const f32x4*)(gt + c) * a[bj][n]; } }
    }
    __device__ __forceinline__ void frag(const f32x4 a, int row, int cs) const {
        const int c = (cs & ~31) + perm32(cs & 31);
        const float* gt = mod + (size_t)batch_of(row) * NMOD + gate_off; float* orow = out + (size_t)row * DM;
        const float* br = inplace ? orow : (row < NP ? xp + (size_t)row * DM : xs + (size_t)(row - NP) * DM);
        const f32x4 r = *(const f32x4*)(br + c) + *(const f32x4*)(gt + c) * a;
        if (inplace) st_wt_f32x4(orow + c, r); else *(f32x4*)(orow + c) = r; }
    EPI_MAIN_CALL
};
struct EpiRelu2 {
    bf16_t* T;
    __device__ __forceinline__ void row(const f32x4 (&a)[2][2], int row, int pn, int wc, int fq) const {
        bf16_t* rp = T + (size_t)row * DFF + pn * BM + wc * 32 + 8 * fq;
#pragma unroll
        for (int bj = 0; bj < 2; ++bj) { f32x4 v0 = a[bj][0], v1 = a[bj][1];
#pragma unroll
            for (int j = 0; j < 4; ++j) { const float r0 = fmaxf(v0[j], 0.f), r1 = fmaxf(v1[j], 0.f); v0[j] = r0 * r0; v1[j] = r1 * r1; }
            st_bf16x8(rp + bj * HALF, v0, v1); }
    }
    __device__ __forceinline__ void frag(f32x4 v, int row, int c) const {
#pragma unroll
        for (int j = 0; j < 4; ++j) { const float r = fmaxf(v[j], 0.f); v[j] = r * r; }
        st_bf16x4(T + (size_t)row * DFF + (c & ~31) + perm32(c & 31), v); }
    EPI_MAIN_CALL
};
struct EpiNull {
    float* sink; int flag;
    __device__ __forceinline__ void row(const f32x4 (&a)[2][2], int row, int pn, int wc, int fq) const {
        if (flag) { *(f32x4*)(sink + (size_t)row * DM + pn * BM + wc * 32 + 4 * fq) = a[0][0] + a[0][1] + a[1][0] + a[1][1]; } }
    EPI_MAIN_CALL
};
__device__ __forceinline__ void spin_until(unsigned* p, unsigned need) { unsigned sp = 0; while (xb_ld(p) < need) { __builtin_amdgcn_s_sleep(1); if (++sp > (1u << 20)) break; } }
template <int MODE>
struct EpiFused {
    static constexpr bool AFTER_DRAIN = true;
    const float *xp, *mod, *g; float* out; bf16_t* H; float* slots; unsigned* cnt; bf16_t* X1;
    __device__ __forceinline__ void fused(f32x4 (&acc)[2][2][4][2], const Unit& u, int wr, int wc, int fr, int fq, float* smem) const {
        const int tid = fresh_tid();
        const float* mb = mod + (size_t)(u.pm >> 3) * NMOD;
        const int cb = u.pn * BM + wc * 32 + 8 * fq, rl0 = wr * 64 + fr;
        float* part = smem; float* rsv = smem + 1024;
        f32x4 gt[2][2];
#pragma unroll
        for (int bj = 0; bj < 2; ++bj)
#pragma unroll
            for (int n = 0; n < 2; ++n) gt[bj][n] = *(const f32x4*)(mb + (MODE ? 5120 : 2048) + cb + bj * HALF + n * 4);
        if constexpr (MODE == 1) {
            uint4 raw[2][4][2];
#pragma unroll
            for (int ai = 0; ai < 2; ++ai)
#pragma unroll
                for (int m = 0; m < 4; ++m) { const size_t ro = (size_t)(u.pm * BM + rl0 + ai * HALF + m * 16) * DM;
#pragma unroll
                    for (int bj = 0; bj < 2; ++bj) raw[ai][m][bj] = *(const uint4*)(X1 + ro + cb + bj * HALF); }
            __builtin_amdgcn_sched_barrier(0);
#pragma unroll
            for (int ai = 0; ai < 2; ++ai)
#pragma unroll
                for (int m = 0; m < 4; ++m) { float ss = 0.f;
#pragma unroll
                    for (int bj = 0; bj < 2; ++bj) { const uint4 q = raw[ai][m][bj];
                        const f32x4 b0 = {bf_lo(q.x), bf_hi(q.x), bf_lo(q.y), bf_hi(q.y)}, b1 = {bf_lo(q.z), bf_hi(q.z), bf_lo(q.w), bf_hi(q.w)};
                        const f32x4 v0 = b0 + gt[bj][0] * acc[ai][bj][m][0], v1 = b1 + gt[bj][1] * acc[ai][bj][m][1]; acc[ai][bj][m][0] = v0; acc[ai][bj][m][1] = v1;
                        ss += v0[0] * v0[0] + v0[1] * v0[1] + v0[2] * v0[2] + v0[3] * v0[3] + v1[0] * v1[0] + v1[1] * v1[1] + v1[2] * v1[2] + v1[3] * v1[3]; }
                    ss += __shfl_xor(ss, 16); ss += __shfl_xor(ss, 32);
                    if (fq == 0) part[(rl0 + ai * HALF + m * 16) * 4 + wc] = ss; }
        } else {
#pragma unroll
        for (int ai = 0; ai < 2; ++ai) {
            f32x4 bs[4][2][2];
#pragma unroll
            for (int m = 0; m < 4; ++m) { const size_t ro = (size_t)(u.pm * BM + rl0 + ai * HALF + m * 16) * DM;
#pragma unroll
                for (int bj = 0; bj < 2; ++bj)
#pragma unroll
                    for (int n = 0; n < 2; ++n) { const int c = cb + bj * HALF + n * 4;
                        if (MODE) { const uint2 q = *(const uint2*)(X1 + ro + c); bs[m][bj][n] = (f32x4){bf_lo(q.x), bf_hi(q.x), bf_lo(q.y), bf_hi(q.y)}; }
                        else bs[m][bj][n] = *(const f32x4*)(xp + ro + c); } }
            __builtin_amdgcn_sched_barrier(0);
#pragma unroll
            for (int m = 0; m < 4; ++m) { float ss = 0.f;
#pragma unroll
                for (int bj = 0; bj < 2; ++bj)
#pragma unroll
                    for (int n = 0; n < 2; ++n) { const f32x4 v = bs[m][bj][n] + gt[bj][n] * acc[ai][bj][m][n]; acc[ai][bj][m][n] = v; ss += v[0] * v[0] + v[1] * v[1] + v[2] * v[2] + v[3] * v[3]; }
                ss += __shfl_xor(ss, 16); ss += __shfl_xor(ss, 32);
                if (fq == 0) part[(rl0 + ai * HALF + m * 16) * 4 + wc] = ss; } }
        }
        __syncthreads();
        if (tid < 256) { const f32x4 q = *(const f32x4*)(part + tid * 4); __hip_atomic_store(slots + (size_t)(u.pm * 4 + u.pn) * 256 + tid, (q[0] + q[1]) + (q[2] + q[3]), __ATOMIC_RELAXED, __HIP_MEMORY_SCOPE_AGENT); }
        asm volatile("s_waitcnt vmcnt(0)" ::: "memory");
        __syncthreads();
        if (tid == 0) { xb_add(cnt + u.pm * 64, 1u); spin_until(cnt + u.pm * 64, 4u); }
        f32x4 gs[2][2], sh[2][2];
#pragma unroll
        for (int bj = 0; bj < 2; ++bj)
#pragma unroll
            for (int n = 0; n < 2; ++n) { const int c = cb + bj * HALF + n * 4; gs[bj][n] = *(const f32x4*)(g + c);
                if (MODE == 0) { gs[bj][n] = gs[bj][n] * (*(const f32x4*)(mb + 4096 + c) + 1.f); sh[bj][n] = *(const f32x4*)(mb + 3072 + c); } }
        __syncthreads();
        if (tid < 256) { float s = 0.f;
#pragma unroll
            for (int q = 0; q < 4; ++q) s += __hip_atomic_load(slots + (size_t)(u.pm * 4 + q) * 256 + tid, __ATOMIC_RELAXED, __HIP_MEMORY_SCOPE_AGENT);
            rsv[tid] = rsqrtf(s * (1.f / DM) + EPS); }
        __syncthreads();
#pragma unroll
        for (int ai = 0; ai < 2; ++ai)
#pragma unroll
            for (int m = 0; m < 4; ++m) { const int rl = rl0 + ai * HALF + m * 16; const size_t ro = (size_t)(u.pm * BM + rl) * DM; const float r = rsv[rl];
#pragma unroll
                for (int bj = 0; bj < 2; ++bj) { const int c = cb + bj * HALF; const f32x4 v0 = acc[ai][bj][m][0], v1 = acc[ai][bj][m][1];
                    if (MODE == 0) { st_bf16x8(X1 + ro + c, v0, v1); st_bf16x8(H + ro + c, v0 * r * gs[bj][0] + sh[bj][0], v1 * r * gs[bj][1] + sh[bj][1]); }
                    else { *(f32x4*)(out + ro + c) = v0 * r * gs[bj][0]; *(f32x4*)(out + ro + c + 4) = v1 * r * gs[bj][1]; } } }
        __syncthreads();
    }
};
struct EpiMod {
    float* mod; const float* b_ada;
    __device__ __forceinline__ void frag(const f32x4 a, int row, int c) const { if (row < NB) *(f32x4*)(mod + (size_t)row * NMOD + c) = a + *(const f32x4*)(b_ada + c); }
    __device__ __forceinline__ void row(const f32x4 (&a)[2][2], int row, int pn, int wc, int fq) const {
        if (row < NB) { const int cb = pn * BM + wc * 32 + 4 * fq;
#pragma unroll
            for (int bj = 0; bj < 2; ++bj)
#pragma unroll
                for (int n = 0; n < 2; ++n) { const int c = cb + bj * HALF + n * 16; *(f32x4*)(mod + (size_t)row * NMOD + c) = a[bj][n] + *(const f32x4*)(b_ada + c); } }
    }
};

template <class Epi>
__device__ __forceinline__ void small_gemm(const bf16_t* __restrict__ A, int nm16, const bf16_t* __restrict__ Bt, int N, int K, const Epi& E, int row_base, float* smem, int blk, int nblk) {
    if (blk < 0) return;
    const int tid = fresh_tid(), w = tid >> 6, lane = tid & 63, fr = lane & 15, fq = lane >> 4;
    const int ntasks = (N / 256) * 4 * nm16, kw = K / 8;
    f32x4* red = (f32x4*)smem;
    for (int t = blk; t < ntasks; t += nblk) {
        const int m16 = t % nm16, r = t / nm16, wc = r & 3, pn = r >> 2;
        const bf16_t* ap = A + (size_t)(m16 * 16 + fr) * K + w * kw + fq * 8;
        const bf16_t* bp = Bt + (size_t)(pn * 256 + wc * 32 + fr) * K + w * kw + fq * 8;
        f32x4 acc[2][2] = {{{0.f, 0.f, 0.f, 0.f}, {0.f, 0.f, 0.f, 0.f}}, {{0.f, 0.f, 0.f, 0.f}, {0.f, 0.f, 0.f, 0.f}}};
#pragma unroll 4
        for (int ks = 0; ks < kw / 32; ++ks) {
            Frag a; a.q = *(const uint4*)(ap + ks * 32);
#pragma unroll
            for (int bj = 0; bj < 2; ++bj)
#pragma unroll
                for (int n = 0; n < 2; ++n) { Frag b; b.q = *(const uint4*)(bp + (size_t)(bj * 128 + n * 16) * K + ks * 32);
                    acc[bj][n] = __builtin_amdgcn_mfma_f32_16x16x32_bf16(b.v, a.v, acc[bj][n], 0, 0, 0); }
        }
#pragma unroll
        for (int i = 0; i < 4; ++i) red[(w * 4 + i) * 64 + lane] = acc[i >> 1][i & 1];
        __syncthreads();
        if (w == 0) { f32x4 s[2][2];
#pragma unroll
            for (int i = 0; i < 4; ++i) { f32x4 v = red[i * 64 + lane];
#pragma unroll
                for (int w2 = 1; w2 < 8; ++w2) v += red[(w2 * 4 + i) * 64 + lane];
                s[i >> 1][i & 1] = v; }
            E.row(s, row_base + m16 * 16 + fr, pn, wc, fq); }
        __syncthreads();
    }
}


template <int KSPLIT, int BATCH, bool SHAREB = false, class Epi>
__device__ __forceinline__ void small_gemm_w(const bf16_t* __restrict__ A, int nm16, const bf16_t* __restrict__ Bt, int N, int K, const Epi& E, int row_base, float* smem) {
    const int tid = fresh_tid(), w = tid >> 6, lane = tid & 63, fr = lane & 15, fq = lane >> 4;
    const int total = nm16 * (N / 16) * KSPLIT, kw = K / KSPLIT;
    f32x4* red = (f32x4*)smem;
    for (int base = blockIdx.x * 8; base < total; base += gridDim.x * 8) {
        const int task = base + w; const bool valid = task < total;
        const int tile = task / KSPLIT, ks = task % KSPLIT, m16 = tile % nm16, n16 = tile / nm16;
        f32x4 acc = {0.f, 0.f, 0.f, 0.f};
        if (KSPLIT == 1 && SHAREB) {
            __syncthreads();
            uint4* Bs = (uint4*)smem; const int nst = kw / 32, per = nst / 8;
            const bf16_t* bpb = Bt + (size_t)((base / nm16) * 16 + fr) * K + fq * 8;
            for (int j = 0; j < per; ++j) { const int s = w * per + j; Bs[s * 64 + lane] = *(const uint4*)(bpb + s * 32); }
            __syncthreads();
            if (valid) {
                const bf16_t* ap = A + (size_t)(m16 * 16 + fr) * K + fq * 8;
                for (int s0 = 0; s0 < nst; s0 += BATCH) { Frag a[BATCH];
#pragma unroll
                    for (int i = 0; i < BATCH; ++i) a[i].q = *(const uint4*)(ap + (s0 + i) * 32);
                    __builtin_amdgcn_sched_barrier(0);
#pragma unroll
                    for (int i = 0; i < BATCH; ++i) { Frag b; b.q = Bs[(s0 + i) * 64 + lane]; acc = __builtin_amdgcn_mfma_f32_16x16x32_bf16(b.v, a[i].v, acc, 0, 0, 0); }
                    __builtin_amdgcn_sched_barrier(0); } }
            __syncthreads();
        } else if (valid) {
            const bf16_t* ap = A + (size_t)(m16 * 16 + fr) * K + ks * kw + fq * 8;
            const bf16_t* bp = Bt + (size_t)(n16 * 16 + fr) * K + ks * kw + fq * 8;
            for (int s0 = 0; s0 < kw / 32; s0 += BATCH) { Frag a[BATCH], b[BATCH];
#pragma unroll
                for (int i = 0; i < BATCH; ++i) { a[i].q = *(const uint4*)(ap + (s0 + i) * 32); b[i].q = *(const uint4*)(bp + (s0 + i) * 32); }
                __builtin_amdgcn_sched_barrier(0);
#pragma unroll
                for (int i = 0; i < BATCH; ++i) acc = __builtin_amdgcn_mfma_f32_16x16x32_bf16(b[i].v, a[i].v, acc, 0, 0, 0);
                __builtin_amdgcn_sched_barrier(0); }
        }
        if (KSPLIT > 1) {
            red[w * 64 + lane] = acc;
            __syncthreads();
            if (ks == 0) {
#pragma unroll
                for (int j = 1; j < KSPLIT; ++j) acc += red[(w + j) * 64 + lane]; }
        }
        if (valid && ks == 0) E.frag(acc, row_base + m16 * 16 + fr, n16 * 16 + 4 * fq);
        if (KSPLIT > 1) __syncthreads();
    }
}

template <class Epi>
__device__ __forceinline__ void gemm_phase(LAS unsigned char* lds, const Gemm g, const StaticOrder& S, const Epi& E, float* smem = nullptr) {
    const int tid = fresh_tid(), wid = __builtin_amdgcn_readfirstlane(tid >> 6), lane = tid & 63, wr = wid >> 2, wc = wid & 3, fr = lane & 15, fq = lane >> 4;
    const int K = g.K, nt = K / BK;
    unsigned voffA[2];
#pragma unroll
    for (int i = 0; i < 2; ++i) { int R, C; stage_rc(tid * 16 + i * 8192, R, C); voffA[i] = (unsigned)(R * K + C) * 2u; }
    const size_t kstep = (size_t)(BK * 2), hstep = (size_t)HALF * K * 2, tstep = 2 * hstep;
    const unsigned ldsw = (unsigned)wid * 1024u;
    const int aoff = lds_byte(wr * 64 + fr, fq * 8), boff = lds_byte(wc * 32 + fr, fq * 8);
#define PG8_SA(b, h) (((b) * 2 + (h)) * HTB)
#define PG8_SB(b, h) ((4 + (b) * 2 + (h)) * HTB)
#define PG8_STAGE(bufoff, gbase, voff) do { _Pragma("unroll") for (int _i = 0; _i < 2; ++_i) \
        __builtin_amdgcn_global_load_lds((const unsigned*)((const char*)(gbase) + (voff)[_i]), (LAS unsigned*)(lds + (bufoff) + ldsw + _i * 8192), 16, 0, 0); } while (0)
#define PG8_LDA(dst, b, h) do { _Pragma("unroll") for (int m = 0; m < 4; ++m) _Pragma("unroll") for (int k = 0; k < 2; ++k) dst[m][k] = *(const LAS bf16x8*)(lds + PG8_SA(b, h) + aoff + m * 2048 + k * 1024); } while (0)
#define PG8_LDB(dst, b, h) do { _Pragma("unroll") for (int n = 0; n < 2; ++n) _Pragma("unroll") for (int k = 0; k < 2; ++k) dst[n][k] = *(const LAS bf16x8*)(lds + PG8_SB(b, h) + boff + n * 2048 + k * 1024); } while (0)
#define PG8_MMA(ai, bj, At, Bt) do { __builtin_amdgcn_s_setprio(1); _Pragma("unroll") for (int m = 0; m < 4; ++m) _Pragma("unroll") for (int n = 0; n < 2; ++n) _Pragma("unroll") for (int k = 0; k < 2; ++k) \
        acc[ai][bj][m][n] = __builtin_amdgcn_mfma_f32_16x16x32_bf16(Bt[n][k], At[m][k], acc[ai][bj][m][n], 0, 0, 0); __builtin_amdgcn_s_setprio(0); } while (0)
#define PG8_WAIT_V(n) asm volatile("s_waitcnt vmcnt(" #n ")" ::: "memory")
#define PG8_WAIT_L(n) asm volatile("s_waitcnt lgkmcnt(" #n ")" ::: "memory")
#define PG8_BAR __builtin_amdgcn_s_barrier()
#define PG8_SCHED __builtin_amdgcn_sched_barrier(0)
    Unit cur, nxt; int ui = 0;
    if (!S.next(0, cur)) return;
    f32x4 acc[2][2][4][2];
#pragma unroll
    for (int a = 0; a < 2; ++a)
#pragma unroll
        for (int b = 0; b < 2; ++b)
#pragma unroll
            for (int m = 0; m < 4; ++m)
#pragma unroll
                for (int n = 0; n < 2; ++n) acc[a][b][m][n] = (f32x4){0.f, 0.f, 0.f, 0.f};
    bf16x8 At[4][2], B0[2][2], B1[2][2];
    const char* cA = (const char*)g.A + (size_t)cur.pm * tstep; const char* cB = (const char*)g.Bt + (size_t)cur.pn * tstep;
    PG8_STAGE(PG8_SB(0, 0), cB, voffA); PG8_STAGE(PG8_SA(0, 0), cA, voffA); PG8_STAGE(PG8_SB(0, 1), cB + hstep, voffA); PG8_STAGE(PG8_SA(0, 1), cA + hstep, voffA);
    if (wr == 1) PG8_BAR;
    PG8_WAIT_V(4); PG8_BAR;
    PG8_STAGE(PG8_SB(1, 0), cB + kstep, voffA); PG8_STAGE(PG8_SA(1, 0), cA + kstep, voffA); PG8_STAGE(PG8_SB(1, 1), cB + hstep + kstep, voffA);
    PG8_WAIT_V(6); PG8_BAR;
    for (;;) {
        const bool has_next = S.next(ui + 1, nxt);
        const char* nA = has_next ? (const char*)g.A + (size_t)nxt.pm * tstep : cA; const char* nB = has_next ? (const char*)g.Bt + (size_t)nxt.pn * tstep : cB;
        for (int t = 0; t < nt; t += 2) {
            const bool last = (t == nt - 2);
            const char* a1 = cA + (size_t)(t + 1) * kstep;
            const char* a2 = last ? nA : cA + (size_t)(t + 2) * kstep; const char* b2 = last ? nB : cB + (size_t)(t + 2) * kstep;
            const char* a3 = a2 + kstep; const char* b3 = b2 + kstep;
            PG8_LDB(B0, 0, 0); PG8_SCHED; PG8_LDA(At, 0, 0); PG8_STAGE(PG8_SA(1, 1), a1 + hstep, voffA);
            PG8_WAIT_L(8); PG8_BAR; PG8_WAIT_L(0); PG8_MMA(0, 0, At, B0); PG8_BAR; PG8_SCHED;
            PG8_LDB(B1, 0, 1); PG8_STAGE(PG8_SB(0, 0), b2, voffA);
            PG8_BAR; PG8_WAIT_L(0); PG8_MMA(0, 1, At, B1); PG8_BAR;
            PG8_LDA(At, 0, 1); PG8_STAGE(PG8_SA(0, 0), a2, voffA);
            PG8_BAR; PG8_WAIT_L(0); PG8_MMA(1, 0, At, B0); PG8_BAR; PG8_SCHED;
            PG8_STAGE(PG8_SB(0, 1), b2 + hstep, voffA);
            PG8_WAIT_V(6); PG8_BAR; PG8_MMA(1, 1, At, B1); PG8_BAR;
            PG8_LDB(B0, 1, 0); PG8_SCHED; PG8_LDA(At, 1, 0); PG8_STAGE(PG8_SA(0, 1), a2 + hstep, voffA);
            PG8_WAIT_L(8); PG8_BAR; PG8_WAIT_L(0); PG8_MMA(0, 0, At, B0); PG8_BAR; PG8_SCHED;
            PG8_LDB(B1, 1, 1); PG8_STAGE(PG8_SB(1, 0), b3, voffA);
            PG8_BAR; PG8_WAIT_L(0); PG8_MMA(0, 1, At, B1); PG8_BAR;
            PG8_LDA(At, 1, 1); PG8_STAGE(PG8_SA(1, 0), a3, voffA);
            PG8_BAR; PG8_WAIT_L(0); PG8_MMA(1, 0, At, B0); PG8_BAR; PG8_SCHED;
            PG8_STAGE(PG8_SB(1, 1), b3 + hstep, voffA);
            PG8_WAIT_V(6); PG8_BAR; PG8_MMA(1, 1, At, B1); PG8_BAR;
        }
        if constexpr (!Epi::AFTER_DRAIN) E(acc, cur, wr, wc, fr, fq);
        if (!has_next) break;
#pragma unroll
        for (int a = 0; a < 2; ++a)
#pragma unroll
            for (int b = 0; b < 2; ++b)
#pragma unroll
                for (int m = 0; m < 4; ++m)
#pragma unroll
                    for (int n = 0; n < 2; ++n) acc[a][b][m][n] = (f32x4){0.f, 0.f, 0.f, 0.f};
        cur = nxt; cA = nA; cB = nB; ++ui;
    }
    PG8_WAIT_V(0);
    if (wr == 0) PG8_BAR;
    PG8_BAR;
    if constexpr (Epi::AFTER_DRAIN) E.fused(acc, cur, wr, wc, fr, fq, smem);
#undef PG8_SA
#undef PG8_SB
#undef PG8_STAGE
#undef PG8_LDA
#undef PG8_LDB
#undef PG8_MMA
#undef PG8_WAIT_V
#undef PG8_WAIT_L
#undef PG8_BAR
#undef PG8_SCHED
}

__device__ __forceinline__ int win_src_col(int np) {
    const int tile = np >> 8, s = np & 255;
    if (tile < 2 || tile == 4 || tile == 5) return np;
    if (tile < 4) { const int bj = s >> 7, wc = (s >> 5) & 3, i = s & 31; return 512 + (tile - 2) * 256 + wc * 64 + bj * 32 + i; }
    return 1536 + (s >> 7) * 512 + (tile - 6) * 128 + (s & 127);
}
template <bool PERMW, bool PERM32>
__device__ __forceinline__ void transpose_cvt(const float* __restrict__ src, bf16_t* __restrict__ dst, int K, int N, float* T, int& tile_ctr, int blk, int nblk) {
    const int tid = fresh_tid(), nkt = K / 64, ntiles = nkt * (N / 256);
    int tl0 = (blk - tile_ctr) % nblk; if (tl0 < 0) tl0 += nblk;
    tile_ctr += ntiles;
    for (int tl = tl0; tl < ntiles; tl += nblk) {
        const int k0 = (tl % nkt) * 64, n0 = (tl / nkt) * 256;
        { const int n4 = (tid & 63) * 4, sc = PERMW ? win_src_col(n0 + n4) : n0 + n4; f32x4 v[8];
#pragma unroll
          for (int i = 0; i < 8; ++i) { const int k = (tid >> 6) + 8 * i; v[i] = *(const f32x4*)(src + (size_t)(k0 + k) * N + sc); }
#pragma unroll
          for (int i = 0; i < 8; ++i) { const int k = (tid >> 6) + 8 * i; *(f32x4*)(T + k * 256 + (n4 ^ (((k >> 3) & 7) << 2))) = v[i]; } }
        __syncthreads();
#pragma unroll
        for (int i = 0; i < 4; ++i) { const int pi = tid + 512 * i, q = pi & 7, nl = pi >> 3, x = PERM32 ? (nl & ~31) + perm32(nl & 31) : nl; const float* tp = T + (8 * q) * 256 + (x ^ (q << 2)); uint4 o;
            o.x = cvt_pk_bf16(tp[0], tp[256]); o.y = cvt_pk_bf16(tp[512], tp[768]); o.z = cvt_pk_bf16(tp[1024], tp[1280]); o.w = cvt_pk_bf16(tp[1536], tp[1792]);
            *(uint4*)(dst + (size_t)(n0 + nl) * K + k0 + 8 * q) = o; }
        __syncthreads();
    }
}
__device__ __forceinline__ void mod_phase(const Params& p, const bf16_t* __restrict__ Sb, float* smem) {
    const int tid = fresh_tid(), w = tid >> 6, lane = tid & 63, fr = lane & 15, fq = lane >> 4;
    f32x4* red = (f32x4*)smem; float* mod = (float*)(p.ws + WS_MOD);
    for (int it = blockIdx.x; it < NMOD / 32; it += gridDim.x) {
        const int col0 = it * 32;
        f32x4 acc[2][9];
#pragma unroll
        for (int i = 0; i < 9; ++i) { acc[0][i] = (f32x4){0.f, 0.f, 0.f, 0.f}; acc[1][i] = (f32x4){0.f, 0.f, 0.f, 0.f}; }
        Frag wfA[4], wfB[4];
#pragma unroll
        for (int kk = 0; kk < 4; ++kk) { const float* wp = p.w_ada + (size_t)(w * 128 + kk * 32 + fq * 8) * NMOD + col0 + 2 * fr;
#pragma unroll
            for (int i = 0; i < 4; ++i) { const float2 v0 = *(const float2*)(wp + (size_t)(2 * i) * NMOD), v1 = *(const float2*)(wp + (size_t)(2 * i + 1) * NMOD);
                wfA[kk].u[i] = cvt_pk_bf16(v0.x, v1.x); wfB[kk].u[i] = cvt_pk_bf16(v0.y, v1.y); } }
#pragma unroll
        for (int kk = 0; kk < 4; ++kk) {
#pragma unroll
            for (int bt = 0; bt < 9; ++bt) { Frag sf; sf.q = *(const uint4*)(Sb + (size_t)(bt * 16 + fr) * DM + w * 128 + kk * 32 + fq * 8);
                acc[0][bt] = __builtin_amdgcn_mfma_f32_16x16x32_bf16(wfA[kk].v, sf.v, acc[0][bt], 0, 0, 0);
                acc[1][bt] = __builtin_amdgcn_mfma_f32_16x16x32_bf16(wfB[kk].v, sf.v, acc[1][bt], 0, 0, 0); } }
        if (w >= 4) {
#pragma unroll
            for (int bt = 0; bt < 9; ++bt) { red[((w - 4) * 18 + bt) * 64 + lane] = acc[0][bt]; red[((w - 4) * 18 + 9 + bt) * 64 + lane] = acc[1][bt]; } }
        __syncthreads();
        if (w < 4) {
#pragma unroll
            for (int bt = 0; bt < 9; ++bt) { acc[0][bt] += red[(w * 18 + bt) * 64 + lane]; acc[1][bt] += red[(w * 18 + 9 + bt) * 64 + lane]; } }
        __syncthreads();
        if (w < 4) {
#pragma unroll
            for (int bt = 0; bt < 9; ++bt) { red[(w * 18 + bt) * 64 + lane] = acc[0][bt]; red[(w * 18 + 9 + bt) * 64 + lane] = acc[1][bt]; } }
        __syncthreads();
        for (int idx = tid; idx < 9 * 64; idx += 512) { const int bt = idx >> 6, l = idx & 63; f32x4 sa = red[bt * 64 + l], sb = red[(9 + bt) * 64 + l];
#pragma unroll
            for (int w2 = 1; w2 < 4; ++w2) { sa += red[(w2 * 18 + bt) * 64 + l]; sb += red[(w2 * 18 + 9 + bt) * 64 + l]; }
            const int b = bt * 16 + (l & 15), j = col0 + (l >> 4) * 8;
            if (b < NB) { float* mp = mod + (size_t)b * NMOD + j;
                *(f32x4*)mp = (f32x4){sa[0], sb[0], sa[1], sb[1]} + *(const f32x4*)(p.b_ada + j);
                *(f32x4*)(mp + 4) = (f32x4){sa[2], sb[2], sa[3], sb[3]} + *(const f32x4*)(p.b_ada + j + 4); } }
        __syncthreads();
    }
}
template <bool FINAL, bool WT = false>
__device__ __forceinline__ void rownorm_phase(const Params& p, const float* g, int sh_off, int sc_off, bool from_out, int r0 = 0, int r1 = NTOK, int nblk = 0) {
    const int tid = fresh_tid(), lane = tid & 63, gw = blockIdx.x * 8 + (tid >> 6), nw = (nblk ? nblk : (int)gridDim.x) * 8;
    const float* mod = (const float*)(p.ws + WS_MOD); bf16_t* H = (bf16_t*)(p.ws + WS_H);
    f32x4 gv[4];
#pragma unroll
    for (int i = 0; i < 4; ++i) gv[i] = *(const f32x4*)(g + (i >> 1) * 512 + lane * 8 + (i & 1) * 4);
    for (int rowb = r0 + gw; rowb < r1; rowb += 4 * nw) {
        f32x4 v[4][4];
#pragma unroll
        for (int q = 0; q < 4; ++q) { const int row = rowb + q * nw;
            if (row < r1) { const float* src = from_out ? p.out + (size_t)row * DM : (row < NP ? p.x_prompt + (size_t)row * DM : p.x_sample + (size_t)(row - NP) * DM);
#pragma unroll
                for (int i = 0; i < 4; ++i) v[q][i] = *(const f32x4*)(src + (i >> 1) * 512 + lane * 8 + (i & 1) * 4); }
            else {
#pragma unroll
                for (int i = 0; i < 4; ++i) v[q][i] = (f32x4){0.f, 0.f, 0.f, 0.f}; } }
        __builtin_amdgcn_sched_barrier(0);
        float rs[4];
#pragma unroll
        for (int q = 0; q < 4; ++q) { float ss = 0.f;
#pragma unroll
            for (int i = 0; i < 4; ++i) ss += v[q][i][0] * v[q][i][0] + v[q][i][1] * v[q][i][1] + v[q][i][2] * v[q][i][2] + v[q][i][3] * v[q][i][3];
#pragma unroll
            for (int o = 1; o < 64; o <<= 1) ss += __shfl_xor(ss, o);
            rs[q] = rsqrtf(ss * (1.f / DM) + EPS); }
#pragma unroll
        for (int q = 0; q < 4; ++q) { const int row = rowb + q * nw;
            if (row < r1) { const float* mb = mod + (size_t)batch_of(row) * NMOD;
#pragma unroll
                for (int h = 0; h < 2; ++h) { const int c = h * 512 + lane * 8;
                    const f32x4 y0 = v[q][2 * h] * rs[q] * gv[2 * h], y1 = v[q][2 * h + 1] * rs[q] * gv[2 * h + 1];
                    if (FINAL) { *(f32x4*)(p.out + (size_t)row * DM + c) = y0; *(f32x4*)(p.out + (size_t)row * DM + c + 4) = y1; }
                    else { if (WT) st_wt_bf16x8(H + (size_t)row * DM + c, y0 * (*(const f32x4*)(mb + sc_off + c) + 1.f) + *(const f32x4*)(mb + sh_off + c),
                                                             y1 * (*(const f32x4*)(mb + sc_off + c + 4) + 1.f) + *(const f32x4*)(mb + sh_off + c + 4)); else st_bf16x8(H + (size_t)row * DM + c, y0 * (*(const f32x4*)(mb + sc_off + c) + 1.f) + *(const f32x4*)(mb + sh_off + c),
                                                             y1 * (*(const f32x4*)(mb + sc_off + c + 4) + 1.f) + *(const f32x4*)(mb + sh_off + c + 4)); } } } }
    }
}
__device__ __forceinline__ void p1_prompt_rows(const Params& p) {
    const int tid = fresh_tid(), lane = tid & 63, gw = blockIdx.x * 8 + (tid >> 6);
    const float* mb = (const float*)(p.ws + WS_MOD) + (size_t)(gw >> 8) * NMOD; bf16_t* H = (bf16_t*)(p.ws + WS_H);
    f32x4 gs[4], sh[4];
#pragma unroll
    for (int i = 0; i < 4; ++i) { const int c = (i >> 1) * 512 + lane * 8 + (i & 1) * 4; gs[i] = *(const f32x4*)(p.g_mix + c) * (*(const f32x4*)(mb + 1024 + c) + 1.f); sh[i] = *(const f32x4*)(mb + c); }
#pragma unroll
    for (int trip = 0; trip < 2; ++trip) { const int rowb = gw * 8 + trip * 4;
        f32x4 v[4][4];
#pragma unroll
        for (int q = 0; q < 4; ++q)
#pragma unroll
            for (int i = 0; i < 4; ++i) v[q][i] = *(const f32x4*)(p.x_prompt + (size_t)(rowb + q) * DM + (i >> 1) * 512 + lane * 8 + (i & 1) * 4);
        __builtin_amdgcn_sched_barrier(0);
#pragma unroll
        for (int q = 0; q < 4; ++q) { float ss = 0.f;
#pragma unroll
            for (int i = 0; i < 4; ++i) ss += v[q][i][0] * v[q][i][0] + v[q][i][1] * v[q][i][1] + v[q][i][2] * v[q][i][2] + v[q][i][3] * v[q][i][3];
#pragma unroll
            for (int o = 1; o < 64; o <<= 1) ss += __shfl_xor(ss, o);
            const float rs = rsqrtf(ss * (1.f / DM) + EPS);
#pragma unroll
            for (int h = 0; h < 2; ++h) st_bf16x8(H + (size_t)(rowb + q) * DM + h * 512 + lane * 8, v[q][2 * h] * rs * gs[2 * h] + sh[2 * h], v[q][2 * h + 1] * rs * gs[2 * h + 1] + sh[2 * h + 1]); }
    }
}
__device__ __forceinline__ void mixer_phase(const Params& p, unsigned char* smem) {
    const int tid = fresh_tid(), w = tid >> 6, lane = tid & 63, fr = lane & 15, fq = lane >> 4;
    const bf16_t* pU = (const bf16_t*)(p.ws + WS_PU); const bf16_t* pV = (const bf16_t*)(p.ws + WS_PV); const bf16_t* pBG = (const bf16_t*)(p.ws + WS_PBG); const bf16_t* pZ = (const bf16_t*)(p.ws + WS_PZ);
    bf16_t* mA = (bf16_t*)(p.ws + WS_MA); const bf16_t* Wt = (const bf16_t*)(p.ws + WS_WTRIL);
    bf16_t* Vs = (bf16_t*)smem;
    for (int item = blockIdx.x; item < 256; item += gridDim.x) {
        const int hh = item & 1, bc = item >> 1, row0 = (bc >> 4) * 2048 + (bc & 15) * 128;
#pragma unroll
        for (int i = 0; i < 8; ++i) { const int pi = tid + 512 * i, s = pi >> 5, c16 = pi & 31, hl = c16 >> 3, d = (c16 & 7) * 8;
            *(uint4*)(Vs + ((hl * 128 + s) * 72 + d)) = *(const uint4*)(pV + (size_t)(row0 + s) * 512 + hh * 256 + c16 * 8); }
        __syncthreads();
        const int hl = w >> 1, thalf = w & 1, head = hh * 4 + hl;
        f32x4 acc[4][4];
#pragma unroll
        for (int a = 0; a < 4; ++a)
#pragma unroll
            for (int b = 0; b < 4; ++b) acc[a][b] = (f32x4){0.f, 0.f, 0.f, 0.f};
#pragma unroll
        for (int ks = 0; ks < 4; ++ks) {
            if (ks < 2 + 2 * thalf) {
                Frag af[4];
#pragma unroll
                for (int mt = 0; mt < 4; ++mt) af[mt].q = *(const uint4*)(Wt + ((size_t)(head * 128 + thalf * 64 + mt * 16 + fr) * 128 + ks * 32 + fq * 8));
#pragma unroll
                for (int nt = 0; nt < 4; ++nt) { Frag bf; const bf16_t* vp = Vs + ((hl * 128 + ks * 32 + fq * 8) * 72 + (nt >> 1) * 32 + perm32((nt & 1) * 16 + fr));
#pragma unroll
                    for (int i = 0; i < 4; ++i) bf.u[i] = (unsigned)vp[(2 * i) * 72] | ((unsigned)vp[(2 * i + 1) * 72] << 16);
#pragma unroll
                    for (int mt = 0; mt < 4; ++mt) acc[mt][nt] = __builtin_amdgcn_mfma_f32_16x16x32_bf16(bf.v, af[mt].v, acc[mt][nt], 0, 0, 0); }
            }
        }
#pragma unroll
        for (int mt = 0; mt < 4; ++mt) { const int t = thalf * 64 + mt * 16 + fr, row = row0 + t; const float bias = p.b_s[head * 128 + t];
#pragma unroll
            for (int pp = 0; pp < 2; ++pp) { const int col = head * 64 + pp * 32 + fq * 8; float u[8]; unpack8(*(const uint4*)(pU + (size_t)row * 512 + col), u);
                f32x4 o0 = acc[mt][2 * pp] + bias, o1 = acc[mt][2 * pp + 1] + bias;
#pragma unroll
                for (int j = 0; j < 4; ++j) { o0[j] *= u[j]; o1[j] *= u[4 + j]; }
                st_bf16x8(mA + (size_t)row * DM + col, o0, o1); } }
        __syncthreads();
    }
    for (int idx = blockIdx.x * 512 + tid; idx < (NP / 8) * 64; idx += gridDim.x * 512) {
        const int row0 = (idx >> 6) * 8, c = (idx & 63) * 8, t0 = row0 & 2047;
        uint4 zq[10], bq[8];
#pragma unroll
        for (int i = 0; i < 10; ++i) { zq[i] = make_uint4(0u, 0u, 0u, 0u); if (i >= 2 || t0 > 0) zq[i] = *(const uint4*)(pZ + (size_t)(row0 + i - 2) * 512 + c); }
#pragma unroll
        for (int i = 0; i < 8; ++i) bq[i] = *(const uint4*)(pBG + (size_t)(row0 + i) * 512 + c);
        float w0[8], w1[8], w2[8];
#pragma unroll
        for (int j = 0; j < 8; ++j) { w0[j] = p.w_conv[c + j]; w1[j] = p.w_conv[512 + c + j]; w2[j] = p.w_conv[1024 + c + j]; }
#pragma unroll
        for (int i = 0; i < 8; ++i) { float za[8], zb[8], zc[8], bg[8], y[8];
            unpack8(zq[i], za); unpack8(zq[i + 1], zb); unpack8(zq[i + 2], zc); unpack8(bq[i], bg);
#pragma unroll
            for (int j = 0; j < 8; ++j) y[j] = bg[j] * (w0[j] * za[j] + w1[j] * zb[j] + w2[j] * zc[j]);
            uint4 o; o.x = cvt_pk_bf16(y[0], y[1]); o.y = cvt_pk_bf16(y[2], y[3]); o.z = cvt_pk_bf16(y[4], y[5]); o.w = cvt_pk_bf16(y[6], y[7]);
            *(uint4*)(mA + (size_t)(row0 + i) * DM + 512 + c) = o; }
    }
    for (int idx = blockIdx.x * 512 + tid; idx < 128 * 64; idx += gridDim.x * 512) {
        const int i = idx >> 6, row = NP + i, c = (idx & 63) * 8;
        float z[8], bg[8], z1[8], z2[8], y[8], u[8], v[8];
        unpack8(*(const uint4*)(pZ + (size_t)row * 512 + c), z); unpack8(*(const uint4*)(pBG + (size_t)row * 512 + c), bg);
        unpack8(*(const uint4*)(pU + (size_t)row * 512 + c), u); unpack8(*(const uint4*)(pV + (size_t)row * 512 + c), v);
        const float* sp = p.state_conv + (size_t)i * 1024 + c;
#pragma unroll
        for (int j = 0; j < 8; ++j) { z2[j] = sp[j]; z1[j] = sp[512 + j]; }
        float* oc = p.out + O_CONVS + (size_t)i * 1024 + c;
        *(f32x4*)oc = (f32x4){z1[0], z1[1], z1[2], z1[3]}; *(f32x4*)(oc + 4) = (f32x4){z1[4], z1[5], z1[6], z1[7]};
        const int h = c >> 6; const float w00 = p.w_s[(size_t)h * 128 * 128], b0 = p.b_s[h * 128];
        uint4 o; o.x = cvt_pk_bf16(u[0] * (w00 * v[0] + b0), u[1] * (w00 * v[1] + b0)); o.y = cvt_pk_bf16(u[2] * (w00 * v[2] + b0), u[3] * (w00 * v[3] + b0));
        o.z = cvt_pk_bf16(u[4] * (w00 * v[4] + b0), u[5] * (w00 * v[5] + b0)); o.w = cvt_pk_bf16(u[6] * (w00 * v[6] + b0), u[7] * (w00 * v[7] + b0));
        *(uint4*)(mA + (size_t)row * DM + c) = o;
#pragma unroll
        for (int j = 0; j < 8; ++j) y[j] = bg[j] * (p.w_conv[c + j] * z2[j] + p.w_conv[512 + c + j] * z1[j] + p.w_conv[1024 + c + j] * z[j]);
        o.x = cvt_pk_bf16(y[0], y[1]); o.y = cvt_pk_bf16(y[2], y[3]); o.z = cvt_pk_bf16(y[4], y[5]); o.w = cvt_pk_bf16(y[6], y[7]);
        *(uint4*)(mA + (size_t)row * DM + 512 + c) = o;
    }
}

__global__ __launch_bounds__(512, 2) void fwd_megakernel(Params p) {
    extern __shared__ __attribute__((aligned(16))) unsigned char shm[];
    __shared__ uint4 xb_words;
    cg::grid_group grid = cg::this_grid();
    LAS unsigned char* lds = (LAS unsigned char*)shm;
    const int tid = fresh_tid(), G = gridDim.x, bid = blockIdx.x;
    if (tid == 0) xb_words = make_uint4(0u, 0u, 0u, 0u);
    __syncthreads();
    const XcdBarrier xb = xcd_barrier_post((unsigned*)(p.ws + WS_BAR), (volatile LAS unsigned*)&xb_words);
    bf16_t* WinT = (bf16_t*)(p.ws + WS_WIN); bf16_t* WoutT = (bf16_t*)(p.ws + WS_WOUT); bf16_t* Wff1T = (bf16_t*)(p.ws + WS_WFF1); bf16_t* Wff2T = (bf16_t*)(p.ws + WS_WFF2);
    bf16_t* WadaT = (bf16_t*)(p.ws + WS_WADA); bf16_t* Sb = (bf16_t*)(p.ws + WS_S);
    bf16_t* H = (bf16_t*)(p.ws + WS_H); bf16_t* mA = (bf16_t*)(p.ws + WS_MA); bf16_t* T = (bf16_t*)(p.ws + WS_R);
    float* mod = (float*)(p.ws + WS_MOD);
    { unsigned* cs = (unsigned*)(p.ws + WS_CNT) + CNT_S * 64;
      for (int i = bid * 512 + tid; i < 144 * DM / 8; i += G * 512) { const int b = i >> 7, k = (i & 127) * 8; uint4 o = {0u, 0u, 0u, 0u};
          if (b < NB) { const float* cp = (b < 8 ? p.c_prompt + (size_t)b * DM : p.c_sample + (size_t)(b - 8) * DM) + k; const f32x4 c0 = *(const f32x4*)cp, c1 = *(const f32x4*)(cp + 4);
              o.x = cvt_pk_bf16(silu_f(c0[0]), silu_f(c0[1])); o.y = cvt_pk_bf16(silu_f(c0[2]), silu_f(c0[3])); o.z = cvt_pk_bf16(silu_f(c1[0]), silu_f(c1[1])); o.w = cvt_pk_bf16(silu_f(c1[2]), silu_f(c1[3])); }
          *(uint4*)(Sb + (size_t)b * DM + k) = o; }
      if (bid < 144 * DM / 8 / 512) { asm volatile("s_waitcnt vmcnt(0)" ::: "memory"); __syncthreads();
          if (fresh_tid() == 0) { __builtin_amdgcn_fence(__ATOMIC_RELEASE, "agent"); asm volatile("s_waitcnt vmcnt(0)" ::: "memory"); xb_add(cs, 1u); } }
      bf16_t* Wt = (bf16_t*)(p.ws + WS_WTRIL);
      for (int i = bid * 512 + tid; i < 8 * 128 * 128; i += G * 512) { const int t = (i >> 7) & 127, s = i & 127; Wt[i] = (bf16_t)(cvt_pk_bf16(s <= t ? p.w_s[i] : 0.f, 0.f) & 0xffffu); }
      { const int nslot = (bid < NMOD / 32) ? 1 : 3, slot0 = (bid < NMOD / 32) ? bid : NMOD / 32 + 3 * (bid - NMOD / 32), nslots = NMOD / 32 + 3 * (G - NMOD / 32);
#pragma unroll 1
        for (int j = 0; j < nslot; ++j) { int ctr = 0;
          transpose_cvt<true, true>(p.w_in, WinT, DM, DIN, (float*)shm, ctr, slot0 + j, nslots);
          transpose_cvt<false, true>(p.w_out, WoutT, DM, DM, (float*)shm, ctr, slot0 + j, nslots);
          transpose_cvt<false, true>(p.w_ff2, Wff2T, DFF, DM, (float*)shm, ctr, slot0 + j, nslots);
          transpose_cvt<false, true>(p.w_ff1, Wff1T, DM, DFF, (float*)shm, ctr, slot0 + j, nslots); } }
      if (p.use_cg_sync) grid.sync();
      asm volatile("s_waitcnt vmcnt(0)" ::: "memory"); __syncthreads();
      if (fresh_tid() == 0) { asm volatile("buffer_inv sc1" ::: "memory"); spin_until(cs, 144 * DM / 8 / 512); asm volatile("s_waitcnt vmcnt(0)" ::: "memory"); }
      __syncthreads();
      mod_phase(p, Sb, (float*)shm); }
    xcd_barrier(xb);
    for (int rep = 0; rep < ((DUP >> 2) & 1) + 1; ++rep) {
    p1_prompt_rows(p);
    rownorm_phase<false>(p, p.g_mix, 0, 1024, false, NP, NTOK);
    }
    xcd_barrier(xb);
    { StaticOrder S; S.init(NP, DIN, G, bid, WGM_G1); Gemm g{H, WinT, NP, DIN, DM};
      EpiIn E{(bf16_t*)(p.ws + WS_PU), (bf16_t*)(p.ws + WS_PV), (bf16_t*)(p.ws + WS_PBG), (bf16_t*)(p.ws + WS_PZ), p.g_v, p.out};
      gemm_phase(lds, g, S, E);
      if (DUP & 8) gemm_phase(lds, g, S, E);
      small_gemm(H + (size_t)NP * DM, 8, WinT, DIN, DM, E, NP, (float*)shm, G == 256 ? bid - 128 : bid, G == 256 ? 128 : G);
      { const int blk = G == 256 ? bid - 128 : bid, nblk = G == 256 ? 128 : G;
        if (blk >= 0) { int ctr = 0;

 } } }
    xcd_barrier(xb);
    for (int rep = 0; rep < ((DUP >> 4) & 1) + 1; ++rep) {
    mixer_phase(p, shm);
    }
    xcd_barrier(xb);
    { StaticOrder S; S.init(NP, DM, G, bid); Gemm g{mA, WoutT, NP, DM, DM};
      EpiRes E{p.x_prompt, p.x_sample, mod, p.out, 2048, 0};
#if FUSE4
      EpiFused<0> EF{p.x_prompt, mod, p.g_ffn, p.out, H, (float*)(p.ws + WS_SLOT), (unsigned*)(p.ws + WS_CNT) + CNT_P4 * 64, (bf16_t*)(p.ws + WS_X1B)};
      gemm_phase(lds, g, S, EF, (float*)shm);
#else
      gemm_phase(lds, g, S, E);
#endif
      small_gemm_w<4, 8>(mA + (size_t)NP * DM, 8, WoutT, DM, DM, E, NP, (float*)shm); }
    xcd_barrier(xb);
#if !FUSE4
    rownorm_phase<false>(p, p.g_ffn, 3072, 4096, true);
    xcd_barrier(xb);
#endif
    { unsigned* ready6 = (unsigned*)(p.ws + WS_CNT) + CNT_READY6 * 64;
#if FUSE4
      if (bid < 16) {
          rownorm_phase<false, true>(p, p.g_ffn, 3072, 4096, true, NP, NTOK, 16);
          asm volatile("s_waitcnt vmcnt(0)" ::: "memory"); __syncthreads();
          if (fresh_tid() == 0) xb_add(ready6, 1u); }
#endif
      StaticOrder S; S.init(NP, DFF, G, bid, WGM_G3); Gemm g{H, Wff1T, NP, DFF, DM};
      EpiRelu2 E{T};
      gemm_phase(lds, g, S, E);
#if FUSE4
      if (fresh_tid() == 0) { spin_until(ready6, 16u); __builtin_amdgcn_fence(__ATOMIC_ACQUIRE, "agent"); asm volatile("s_waitcnt vmcnt(0)" ::: "memory"); }
      __syncthreads();
#endif
      small_gemm_w<1, 16, true>(H + (size_t)NP * DM, 8, Wff1T, DFF, DM, E, NP, (float*)shm); }
    xcd_barrier(xb);
    { unsigned* done7 = (unsigned*)(p.ws + WS_CNT) + CNT_DONE7 * 64;
      StaticOrder S; S.init(NP, DM, G, bid); Gemm g{T, Wff2T, NP, DM, DFF};
      EpiRes E{p.x_prompt, p.x_sample, mod, p.out, 5120, 1};
#if FUSE7
      small_gemm_w<4, 16>(T + (size_t)NP * DFF, 8, Wff2T, DM, DFF, E, NP, (float*)shm);
      asm volatile("s_waitcnt vmcnt(0)" ::: "memory"); __syncthreads();
      if (fresh_tid() == 0) xb_add(done7, 1u);
      EpiFused<1> EF{p.x_prompt, mod, p.g_final, p.out, H, (float*)(p.ws + WS_SLOT) + 64 * 4 * 256, (unsigned*)(p.ws + WS_CNT) + CNT_P7 * 64, (bf16_t*)(p.ws + WS_X1B)};
      gemm_phase(lds, g, S, EF, (float*)shm);
      if (bid < 16) {
          if (fresh_tid() == 0) { spin_until(done7, (unsigned)G); __builtin_amdgcn_fence(__ATOMIC_ACQUIRE, "agent"); asm volatile("s_waitcnt vmcnt(0)" ::: "memory"); }
          __syncthreads();
          rownorm_phase<true>(p, p.g_final, 0, 0, true, NP, NTOK, 16); }
#else
      gemm_phase(lds, g, S, E);
      small_gemm_w<4, 16>(T + (size_t)NP * DFF, 8, Wff2T, DM, DFF, E, NP, (float*)shm);
#endif
    }
#if !FUSE7
    xcd_barrier(xb);
    rownorm_phase<true>(p, p.g_final, 0, 0, true);
#endif
}

extern "C" void kernel_launch(void* const* d_in, const int* in_sizes, int n_in, void* d_out, int out_size, void* d_ws, size_t ws_size, hipStream_t stream) {
    static int grid = 0;
    if (grid == 0) {
        if (n_in != 18 || in_sizes[0] != NP * DM || (size_t)out_size != O_END || ws_size < WS_END) {
            fprintf(stderr, "kernel_launch: unexpected shapes (n_in %d, in0 %d, out %d, ws %zu, need %zu)\n", n_in, n_in > 0 ? in_sizes[0] : -1, out_size, ws_size, (size_t)WS_END); grid = -1; return; }
        int dev = 0, cus = 0, per_cu = 0;
        (void)hipGetDevice(&dev); (void)hipDeviceGetAttribute(&cus, hipDeviceAttributeMultiprocessorCount, dev);
        if (hipFuncSetAttribute((const void*)fwd_megakernel, hipFuncAttributeMaxDynamicSharedMemorySize, LDS_BYTES) != hipSuccess) { fprintf(stderr, "kernel_launch: hipFuncSetAttribute failed\n"); grid = -1; return; }
        if (hipOccupancyMaxActiveBlocksPerMultiprocessor(&per_cu, (const void*)fwd_megakernel, 512, LDS_BYTES) != hipSuccess || per_cu < 1) { fprintf(stderr, "kernel_launch: occupancy query failed (%d)\n", per_cu); grid = -1; return; }
        grid = cus * per_cu;
        if (grid != 256) { fprintf(stderr, "kernel_launch: built for 256 co-resident workgroups, got %d\n", grid); grid = -1; return; }
    }
    if (grid < 0) return;
    Params p{};
    p.x_prompt = (const float*)d_in[0]; p.x_sample = (const float*)d_in[1]; p.c_prompt = (const float*)d_in[2]; p.c_sample = (const float*)d_in[3]; p.state_conv = (const float*)d_in[4];
    p.g_mix = (const float*)d_in[5]; p.w_ada = (const float*)d_in[6]; p.b_ada = (const float*)d_in[7]; p.w_in = (const float*)d_in[8]; p.g_v = (const float*)d_in[9];
    p.w_s = (const float*)d_in[10]; p.b_s = (const float*)d_in[11]; p.w_conv = (const float*)d_in[12]; p.w_out = (const float*)d_in[13]; p.g_ffn = (const float*)d_in[14];
    p.w_ff1 = (const float*)d_in[15]; p.w_ff2 = (const float*)d_in[16]; p.g_final = (const float*)d_in[17];
    p.out = (float*)d_out; p.ws = (unsigned char*)d_ws;
    if (hipMemsetAsync((char*)d_ws + WS_BAR, 0, 16384 + CNT_BYTES, stream) != hipSuccess) { fprintf(stderr, "kernel_launch: memset failed\n"); return; }
    void* args[] = {&p};
    hipError_t e = hipLaunchCooperativeKernel((const void*)fwd_megakernel, dim3(grid), dim3(512), args, LDS_BYTES, stream);
    if (e != hipSuccess) fprintf(stderr, "cooperative launch failed: %s (grid %d)\n", hipGetErrorString(e), grid);
}
```
